# Optimizing an MI355X kernel written in HIP

```python
import jax, jax.numpy as jnp
from jax import lax
import numpy as np

D_MODEL = 2048
BATCH = 4
SEQ = 4096
DEPTH = 2

CTX_LEN = 256
GRID_W = 64
HEAD_DIM = 128
N_HG = 4
N_NA = 8
N_CV = 4
HG_W = N_HG * HEAD_DIM
NA_W = N_NA * HEAD_DIM
CV_W = N_CV * HEAD_DIM
MIX_W = HG_W + NA_W + CV_W
IN_SPLITS = (HG_W, HG_W, HG_W, NA_W, NA_W, HG_W, HG_W, NA_W, CV_W, CV_W, CV_W)
IN_W = sum(IN_SPLITS)
CTX_PIECES = 5
HG_CHUNK = 64
NA_WIN_R = 8
NA_WIN_C = 16
NA_QBLK_C = 16
NA_KEY_C = 32
CONV_W = 3
D_FF = 5632
EPS = 1e-6
F_FLOOR = 1e-30
ATTN_SCALE = HEAD_DIM ** -0.5
NEG_INF = -1e30

kernel_name = 'hybrid_hgrn2_natten_shortconv_dit_block'


def _rms_norm(x, w):
    xf = x.astype(jnp.float32)
    y = xf * lax.rsqrt(jnp.mean(xf * xf, axis=-1, keepdims=True) + EPS)
    return (y * w.astype(jnp.float32)).astype(x.dtype)


def _modulate(h, shift, scale):
    return h * (1 + scale) + shift


def _heads(a):
    return a.reshape(a.shape[:-1] + (a.shape[-1] // HEAD_DIM, HEAD_DIM))


def _merge(a):
    return a.reshape(a.shape[:-2] + (a.shape[-2] * a.shape[-1],))


def _flip(a):
    return a[:, ::-1]


def _split_cols(u, n_pieces):
    cuts = [int(v) for v in np.cumsum(IN_SPLITS[:n_pieces])[:-1]]
    return jnp.split(u, cuts, axis=-1)


def _dwconv(x, w):
    l_ = x.shape[1]
    pad = CONV_W // 2
    xp = jnp.pad(x, ((0, 0), (pad, pad), (0, 0)))
    out = xp[:, :l_] * w[0]
    for t in range(1, CONV_W):
        out = out + xp[:, t:t + l_] * w[t]
    return out


def _hgrn2_forget(z, lb):
    zf = z.astype(jnp.float32)
    f = lb + (1.0 - lb) * jax.nn.sigmoid(zf)
    log_f = jnp.log(jnp.maximum(f, F_FLOOR))
    k = (1.0 - lb) * jax.nn.sigmoid(-zf)
    return _heads(log_f), _heads(k)


def _hgrn2_scan(log_f, k, v, s0, q=None):
    b_, l_, h_, _ = log_f.shape
    n_chunks = l_ // HG_CHUNK

    def chunks(a):
        return a.reshape(b_, n_chunks, HG_CHUNK, h_, a.shape[-1]).transpose(1, 0, 3, 2, 4)

    tri = jnp.tril(jnp.ones((HG_CHUNK, HG_CHUNK), dtype=bool))[:, :, None]
    with_out = q is not None
    xs = (chunks(log_f), chunks(k), chunks(v)) + ((chunks(q),) if with_out else ())

    def step(s, inp):
        g, kc, vc = inp[0], inp[1], inp[2]
        cum = jnp.cumsum(g, axis=2)
        tot = cum[:, :, -1]
        s_new = jnp.exp(tot)[..., None] * s + jnp.einsum('bhcd,bhce->bhde', kc * jnp.exp(tot[:, :, None] - cum), vc)
        if not with_out:
            return s_new, None
        qc = inp[3]
        o_inter = jnp.einsum('bhcd,bhde->bhce', qc * jnp.exp(cum), s)
        diff = cum[:, :, :, None, :] - cum[:, :, None, :, :]
        decay = jnp.exp(jnp.where(tri, diff, NEG_INF))
        att = jnp.einsum('bhid,bhjd,bhijd->bhij', qc, kc, decay)
        return s_new, o_inter + jnp.einsum('bhij,bhje->bhie', att, vc)

    s_fin, o = lax.scan(step, s0, xs)
    if not with_out:
        return s_fin, None
    return s_fin, o.transpose(1, 0, 3, 2, 4).reshape(b_, l_, h_, v.shape[-1])


def _hgrn2_readout(o, g, w):
    return _merge(_rms_norm(o, w)).astype(g.dtype) * jax.nn.silu(g)


def _neighbourhood_attention(q, k, v, k_ctx, v_ctx, rpb, rows):
    b_, n_, h_, d_ = q.shape
    win_r = min(NA_WIN_R, rows)
    n_cb = GRID_W // NA_QBLK_C
    qcol = np.arange(GRID_W).reshape(n_cb, NA_QBLK_C)
    kstart = np.clip(np.arange(n_cb) * NA_QBLK_C - NA_WIN_C // 2, 0, GRID_W - NA_KEY_C)
    kcol = kstart[:, None] + np.arange(NA_KEY_C)[None]
    wstart = np.clip(qcol - NA_WIN_C // 2, 0, GRID_W - NA_WIN_C)
    col_ok = (kcol[:, None, :] >= wstart[:, :, None]) & (kcol[:, None, :] < wstart[:, :, None] + NA_WIN_C)
    mask = jnp.asarray(col_ok[:, :, None, :])
    idx_c = jnp.asarray(np.clip(kcol[:, None, :] - qcol[:, :, None] + NA_WIN_C - 1, 0, 2 * NA_WIN_C - 2)[:, :, None, :])
    qg = q.reshape(b_, rows, GRID_W, h_, d_)
    kg = k.reshape(b_, rows, GRID_W, h_, d_)
    vg = v.reshape(b_, rows, GRID_W, h_, d_)
    n_loc = win_r * NA_KEY_C

    def row_block(r):
        rs = jnp.clip(r - win_r // 2, 0, rows - win_r)
        qr = lax.dynamic_index_in_dim(qg, r, axis=1, keepdims=False).reshape(b_, n_cb, NA_QBLK_C, h_, d_)
        kr = lax.dynamic_slice_in_dim(kg, rs, win_r, axis=1)[:, :, kcol]
        vr = lax.dynamic_slice_in_dim(vg, rs, win_r, axis=1)[:, :, kcol]
        idx_r = (rs + jnp.arange(win_r) - r + NA_WIN_R - 1)[None, None, :, None]
        bias = rpb[:, idx_r, idx_c].astype(jnp.float32)
        s_loc = jnp.einsum('bmqhd,brmkhd->bhmqrk', qr, kr).astype(jnp.float32) * ATTN_SCALE
        s_loc = jnp.where(mask, s_loc + bias, NEG_INF)
        s_ctx = jnp.einsum('bmqhd,bkhd->bhmqk', qr, k_ctx).astype(jnp.float32) * ATTN_SCALE
        logits = jnp.concatenate([s_loc.reshape(s_loc.shape[:4] + (n_loc,)), s_ctx], axis=-1)
        p = jax.nn.softmax(logits, axis=-1).astype(v.dtype)
        p_loc = p[..., :n_loc].reshape(s_loc.shape)
        o = jnp.einsum('bhmqrk,brmkhd->bmqhd', p_loc, vr) + jnp.einsum('bhmqk,bkhd->bmqhd', p[..., n_loc:], v_ctx)
        return o.reshape(b_, GRID_W, h_, d_)

    o = lax.map(row_block, jnp.arange(rows))
    return jnp.moveaxis(o, 0, 1).reshape(b_, n_, h_, d_)


def _context_attention(q, k, v):
    s = jnp.einsum('bqhd,bkhd->bhqk', q, k).astype(jnp.float32) * ATTN_SCALE
    p = jax.nn.softmax(s, axis=-1).astype(v.dtype)
    return jnp.einsum('bhqk,bkhd->bqhd', p, v)


def _short_conv(b_gate, c_gate, v, w):
    return b_gate * _dwconv(c_gate * v, w)


def _conv_ffn(h, w_up, cw, cb, w_down):
    u = _dwconv(h @ w_up, cw) + cb
    gate, val = jnp.split(u, 2, axis=-1)
    return (jax.nn.silu(gate) * val) @ w_down


def _layer(x, ctx, ada, ada_ctx, lb_fw, lb_bw, ln1, ln2, w_in, hg_norm, q_norm, k_norm, rpb, na_onorm,
           cv_w, cv_onorm, w_out, w_up, f_cw, f_cb, w_down, rows, last):
    sh1, sc1, g1, sh2, sc2, g2 = jnp.split(ada[:, None, :], 6, axis=-1)
    cm = jnp.split(ada_ctx, 2 if last else 6)
    h = _modulate(_rms_norm(x, ln1), sh1, sc1)
    hc = _modulate(_rms_norm(ctx, ln1), cm[0], cm[1])
    (f_fw, f_bw, i_v, na_k, na_v, hg_q, hg_g, na_q, cv_b, cv_c, cv_v) = _split_cols(h @ w_in, len(IN_SPLITS))
    n_c = CTX_PIECES if last else len(IN_SPLITS)
    uc = _split_cols(hc @ w_in[:, :sum(IN_SPLITS[:n_c])], n_c)

    s0 = jnp.zeros((x.shape[0], N_HG, HEAD_DIM, HEAD_DIM), jnp.float32)
    cf_fw, ck_fw = _hgrn2_forget(uc[0], lb_fw)
    cf_bw, ck_bw = _hgrn2_forget(uc[1], lb_bw)
    c_val = _heads(uc[2].astype(jnp.float32))
    c_q = None if last else _heads(jax.nn.silu(uc[5]).astype(jnp.float32))
    s_fw, co_fw = _hgrn2_scan(cf_fw, ck_fw, c_val, s0, c_q)
    s_bw, co_bw = _hgrn2_scan(_flip(cf_bw), _flip(ck_bw), _flip(c_val), s0, None if last else _flip(c_q))
    lf_fw, lk_fw = _hgrn2_forget(f_fw, lb_fw)
    lf_bw, lk_bw = _hgrn2_forget(f_bw, lb_bw)
    l_val = _heads(i_v.astype(jnp.float32))
    l_q = _heads(jax.nn.silu(hg_q).astype(jnp.float32))
    _, o_fw = _hgrn2_scan(lf_fw, lk_fw, l_val, s_fw, l_q)
    _, o_bw = _hgrn2_scan(_flip(lf_bw), _flip(lk_bw), _flip(l_val), s_bw, _flip(l_q))
    hg_out = _hgrn2_readout(o_fw + _flip(o_bw), hg_g, hg_norm)

    k_c = _rms_norm(_heads(uc[3]), k_norm)
    v_c = _heads(uc[4])
    na_o = _neighbourhood_attention(_rms_norm(_heads(na_q), q_norm), _rms_norm(_heads(na_k), k_norm),
                                    _heads(na_v), k_c, v_c, rpb, rows)
    na_onorm_h = na_onorm.reshape(N_NA, HEAD_DIM)
    na_out = _merge(_rms_norm(na_o, na_onorm_h))

    cv_onorm_h = cv_onorm.reshape(N_CV, HEAD_DIM)
    cv_out = _merge(_rms_norm(_heads(_short_conv(cv_b, cv_c, cv_v, cv_w)), cv_onorm_h))

    x = x + g1 * (jnp.concatenate([hg_out, na_out, cv_out], axis=-1) @ w_out)
    x = x + g2 * _conv_ffn(_modulate(_rms_norm(x, ln2), sh2, sc2), w_up, f_cw, f_cb, w_down)
    if last:
        return x, None

    hg_c = _hgrn2_readout(co_fw + _flip(co_bw), uc[6], hg_norm)
    na_c = _merge(_rms_norm(_context_attention(_rms_norm(_heads(uc[7]), q_norm), k_c, v_c), na_onorm_h))
    cv_co = _merge(_rms_norm(_heads(_short_conv(uc[8], uc[9], uc[10], cv_w)), cv_onorm_h))
    ctx = ctx + cm[2] * (jnp.concatenate([hg_c, na_c, cv_co], axis=-1) @ w_out)
    ctx = ctx + cm[5] * _conv_ffn(_modulate(_rms_norm(ctx, ln2), cm[3], cm[4]), w_up, f_cw, f_cb, w_down)
    return x, ctx


def setup_inputs(seed: int = 0) -> dict:
    key = jax.random.key(seed)
    ks = jax.random.split(key, 24)
    d = D_MODEL

    def nrm(k, shape, scale):
        return jax.random.normal(k, shape, jnp.float32) * scale

    return {
        'x': nrm(ks[0], (BATCH, SEQ, d), 1.0),
        'c': nrm(ks[1], (BATCH, d), 1.0),
        'ctx': nrm(ks[2], (BATCH, CTX_LEN, d), 1.0),
        'c_ctx': nrm(ks[3], (d,), 1.0),
        'w_ada': nrm(ks[4], (DEPTH, d, 6 * d), 0.5 * d ** -0.5),
        'b_ada': nrm(ks[5], (DEPTH, 6 * d), 0.01),
        'ln1_w': 1.0 + nrm(ks[6], (DEPTH, d), 0.02),
        'ln2_w': 1.0 + nrm(ks[7], (DEPTH, d), 0.02),
        'w_in': nrm(ks[8], (DEPTH, d, IN_W), d ** -0.5),
        'hg_lb_logits': nrm(ks[9], (2, DEPTH, HG_W), 0.5),
        'hg_norm_w': 1.0 + nrm(ks[10], (DEPTH, HEAD_DIM), 0.02),
        'na_q_norm_w': 1.0 + nrm(ks[11], (DEPTH, HEAD_DIM), 0.02),
        'na_k_norm_w': 1.0 + nrm(ks[12], (DEPTH, HEAD_DIM), 0.02),
        'na_rpb': nrm(ks[13], (DEPTH, N_NA, 2 * NA_WIN_R - 1, 2 * NA_WIN_C - 1), 0.1),
        'na_out_norm_w': 1.0 + nrm(ks[14], (DEPTH, NA_W), 0.02),
        'cv_w': nrm(ks[15], (DEPTH, CONV_W, CV_W), CONV_W ** -0.5),
        'cv_out_norm_w': 1.0 + nrm(ks[16], (DEPTH, CV_W), 0.02),
        'w_out': nrm(ks[17], (DEPTH, MIX_W, d), MIX_W ** -0.5),
        'w_up': nrm(ks[18], (DEPTH, d, 2 * D_FF), d ** -0.5),
        'ffn_conv_w': nrm(ks[19], (DEPTH, CONV_W, 2 * D_FF), CONV_W ** -0.5),
        'ffn_conv_b': nrm(ks[20], (DEPTH, 2 * D_FF), 0.01),
        'w_down': nrm(ks[21], (DEPTH, D_FF, d), D_FF ** -0.5),
    }


def reference(x, c, ctx, c_ctx, w_ada, b_ada, ln1_w, ln2_w, w_in, hg_lb_logits, hg_norm_w, na_q_norm_w,
              na_k_norm_w, na_rpb, na_out_norm_w, cv_w, cv_out_norm_w, w_out, w_up, ffn_conv_w, ffn_conv_b, w_down):
    rows = x.shape[1] // GRID_W
    lb_sm = jax.nn.softmax(hg_lb_logits.astype(jnp.float32), axis=1)
    lb_all = jnp.cumsum(lb_sm, axis=1) - lb_sm[:, :1]
    silu_c = jax.nn.silu(c)
    silu_cc = jax.nn.silu(c_ctx)
    for l in range(DEPTH):
        last = l == DEPTH - 1
        ada = silu_c @ w_ada[l] + b_ada[l]
        n_ada = (2 if last else 6) * D_MODEL
        ada_ctx = silu_cc @ w_ada[l][:, :n_ada] + b_ada[l][:n_ada]
        x, ctx = _layer(x, ctx, ada, ada_ctx, lb_all[0, l], lb_all[1, l], ln1_w[l], ln2_w[l], w_in[l],
                        hg_norm_w[l], na_q_norm_w[l], na_k_norm_w[l], na_rpb[l], na_out_norm_w[l], cv_w[l],
                        cv_out_norm_w[l], w_out[l], w_up[l], ffn_conv_w[l], ffn_conv_b[l], w_down[l], rows, last)
    return x
```

```cpp
#include <hip/hip_runtime.h>
#include <hip/hip_cooperative_groups.h>
#include <cstdio>
#include <cstdint>
namespace cg = cooperative_groups;

#define LAS __attribute__((address_space(3)))
#define GAS __attribute__((address_space(1)))
typedef unsigned short bf16_t;
typedef short bf16x8 __attribute__((ext_vector_type(8)));
typedef float f32x4 __attribute__((ext_vector_type(4)));
typedef unsigned u32x4 __attribute__((ext_vector_type(4)));
typedef unsigned u32x2 __attribute__((ext_vector_type(2)));

constexpr int DM = 2048, NB = 4, SEQ = 4096, CTXL = 256;
constexpr int ML = NB * SEQ;
constexpr int MC = NB * CTXL;
constexpr int MA = ML + MC;
constexpr int INW = 7168, FF = 5632, FF2 = 11264;
constexpr int ADA_W = 12288;
constexpr float EPS = 1e-6f;
constexpr float ATTN_SCALE = 0.08838834764831845f;
constexpr int NCHUNK = 68;
constexpr int C_FFW = 0, C_FBW = 512, C_IV = 1024, C_NAK = 1536, C_NAV = 2560, C_HGQ = 3584, C_HGG = 4096, C_NAQ = 4608, C_CVB = 5632, C_CVC = 6144, C_CVV = 6656;

constexpr size_t MiB = 1u << 20;
constexpr size_t WS_ADA = 0;
constexpr size_t WS_BAR = 512 * 1024;
constexpr size_t WS_CTR = 768 * 1024;
constexpr size_t WS_DC = 1 * MiB;
constexpr size_t WS_WT = 3 * MiB;
constexpr size_t WT_LAYER = 102 * MiB, WT_OUT_OFF = 28 * MiB, WT_UP_OFF = 36 * MiB, WT_DN_OFF = 80 * MiB;
constexpr size_t WS_X2B = 3 * MiB;
constexpr size_t WS_HA = 207 * MiB;
constexpr size_t WS_X1 = 275 * MiB;
constexpr size_t WS_CTX2 = 411 * MiB;
constexpr size_t WS_U = 419 * MiB;
constexpr size_t WS_EDGE = WS_U + 187 * MiB;
constexpr size_t WS_MIX = 657 * MiB;
constexpr size_t WS_PART = 725 * MiB;
constexpr size_t WS_END = 757 * MiB;
constexpr int LDS_BYTES = 147456;

struct Params {
    const float *x, *c, *ctx, *c_ctx, *w_ada, *b_ada, *ln1_w, *ln2_w, *w_in, *hg_lb, *hg_norm_w, *q_norm_w, *k_norm_w, *rpb, *na_onorm, *cv_w, *cv_onorm, *w_out, *w_up, *f_cw, *f_cb, *w_down;
    float* out; unsigned char* ws;
};

__device__ __forceinline__ float bf2f(bf16_t v) { return __uint_as_float(((unsigned)v) << 16); }
__device__ __forceinline__ unsigned pk2(float lo, float hi) { unsigned r; asm("v_cvt_pk_bf16_f32 %0, %1, %2" : "=v"(r) : "v"(lo), "v"(hi)); return r; }
__device__ __forceinline__ unsigned f2bf(float f) { return pk2(f, f) & 0xffffu; }
__device__ __forceinline__ float lo16(unsigned w) { return __uint_as_float(w << 16); }
__device__ __forceinline__ float hi16(unsigned w) { return __uint_as_float(w & 0xffff0000u); }
__device__ __forceinline__ float rcpf_(float x) { return __builtin_amdgcn_rcpf(x); }
__device__ __forceinline__ float siluf_(float x) { return x * rcpf_(1.f + __expf(-x)); }
__device__ __forceinline__ float xshfl(float v, int mask, int lane) { return __builtin_bit_cast(float, __builtin_amdgcn_ds_bpermute((lane ^ mask) << 2, __builtin_bit_cast(int, v))); }
__device__ __forceinline__ float wave_sum(float v, int lane) {
#pragma unroll
    for (int o = 1; o < 64; o <<= 1) v += xshfl(v, o, lane);
    return v;
}
__device__ __forceinline__ float sum16(float v, int lane) { v += xshfl(v, 1, lane); v += xshfl(v, 2, lane); v += xshfl(v, 4, lane); v += xshfl(v, 8, lane); return v; }
__device__ __forceinline__ float max16(float v, int lane) { v = fmaxf(v, xshfl(v, 1, lane)); v = fmaxf(v, xshfl(v, 2, lane)); v = fmaxf(v, xshfl(v, 4, lane)); v = fmaxf(v, xshfl(v, 8, lane)); return v; }
__device__ __forceinline__ const float* rowp(const float* lat, const float* cx, int r) { return r < ML ? lat + (size_t)r * DM : cx + (size_t)(r - ML) * DM; }
__device__ __forceinline__ void unpack8(u32x4 w, float (&f)[8]) {
    f[0] = lo16(w.x); f[1] = hi16(w.x); f[2] = lo16(w.y); f[3] = hi16(w.y); f[4] = lo16(w.z); f[5] = hi16(w.z); f[6] = lo16(w.w); f[7] = hi16(w.w);
}
__device__ __forceinline__ bf16x8 as_frag(u32x4 w) { union { u32x4 u; bf16x8 b; } c; c.u = w; return c.b; }
__device__ __forceinline__ float dpp_ror1(float v) { const int iv = __builtin_bit_cast(int, v); return __builtin_bit_cast(float, __builtin_amdgcn_update_dpp(iv, iv, 0x121, 0xf, 0xf, false)); }
__device__ __forceinline__ float dpp_ror15(float v) { const int iv = __builtin_bit_cast(int, v); return __builtin_bit_cast(float, __builtin_amdgcn_update_dpp(iv, iv, 0x12F, 0xf, 0xf, false)); }
template <int CTRL> __device__ __forceinline__ float dppf(float v) { const int iv = __builtin_bit_cast(int, v); return __builtin_bit_cast(float, __builtin_amdgcn_update_dpp(iv, iv, CTRL, 0xf, 0xf, false)); }
__device__ __forceinline__ float sum16d(float v) { v += dppf<0xB1>(v); v += dppf<0x4E>(v); v += dppf<0x141>(v); v += dppf<0x128>(v); return v; }
__device__ __forceinline__ float max16d(float v) { v = fmaxf(v, dppf<0xB1>(v)); v = fmaxf(v, dppf<0x4E>(v)); v = fmaxf(v, dppf<0x141>(v)); v = fmaxf(v, dppf<0x128>(v)); return v; }
typedef short s16x4 __attribute__((ext_vector_type(4)));
__device__ __forceinline__ int opaque_v(int x) { asm volatile("" : "+v"(x)); return x; }
__device__ __forceinline__ int opaque_s(int x) { asm volatile("" : "+s"(x)); return x; }
#define MFMA16(a, b, c) __builtin_amdgcn_mfma_f32_16x16x32_bf16((a), (b), (c), 0, 0, 0)

namespace pg8 {
constexpr int BM = 256, BK = 64, HALF = 128, HTB = HALF * BK * 2, STAGE_BYTES = 8 * HTB, NXCD = 8, WGM = 8;
__device__ __forceinline__ int lds_byte(int r, int c) { const int st = (r >> 4) * 2 + (c >> 5), rr = r & 15, cc = c & 31, ob = rr * 64 + cc * 2; return st * 1024 + (ob ^ (((ob >> 9) & 1) << 5)); }
__device__ __forceinline__ void stage_rc(int b, int& R, int& C) { const int st = b / 1024, sb = b % 1024, swz = sb ^ (((sb >> 9) & 1) << 5); R = (st >> 1) * 16 + swz / 64; C = (st & 1) * 32 + (swz % 64) / 2; }
__device__ __forceinline__ int perm32(int rho) { const int n = rho >> 4, i = rho & 15; return 8 * (i >> 2) + 4 * n + (i & 3); }
struct Unit { int pm, pn, kt0, nt; };
struct Gemm { const bf16_t* A; const bf16_t* Bt; int K; };
struct SegOrder {
    int nM, nN, n0, nM1, n1, G, c, ntf, ksp;
    __device__ void init(int nM0_, int nN0_, int nM1_, int nN1_, int G_, int c_, int ntf_, int ksp_ = 1) { nM = nM0_; nN = nN0_; n0 = nM * nN; nM1 = nM1_; n1 = nM1_ * nN1_ * ksp_; G = G_; c = c_; ntf = ntf_; ksp = ksp_; }
    __device__ bool next(int i, Unit& u) const {
        const long L = (long)i * G + c; if (L >= n0 + n1) return false;
        u.kt0 = 0; u.nt = ntf;
        if (L >= n0) { int r = (int)L - n0; const int ks = r % ksp; r /= ksp; u.pm = 64 + (r % nM1); u.pn = r / nM1; u.nt = ntf / ksp; u.kt0 = ks * u.nt; return true; }
        int wgid = (int)L; { const int q = n0 / NXCD, r = n0 % NXCD, xcd = wgid % NXCD, off = wgid / NXCD; wgid = (xcd < r ? xcd * (q + 1) : r * (q + 1) + (xcd - r) * q) + off; }
        const int nig = WGM * nN, gid = wgid / nig, fm = gid * WGM, gsz = (nM - fm) < WGM ? (nM - fm) : WGM;
        u.pm = fm + ((wgid % nig) % gsz); u.pn = (wgid % nig) / gsz; return true;
    }
};
__device__ __forceinline__ unsigned cvt_pk_bf16(float lo, float hi) { unsigned r; asm volatile("v_cvt_pk_bf16_f32 %0, %1, %2" : "=v"(r) : "v"(lo), "v"(hi)); return r; }

template <class Epi>
__device__ __forceinline__ void gemm_phase(LAS unsigned char* lds, const Gemm g, const SegOrder& S, const Epi& E, const int tid) {
    const int wid = __builtin_amdgcn_readfirstlane(tid >> 6), lane = tid & 63, wr = wid >> 2, wc = wid & 3, fr = lane & 15, fq = lane >> 4;
    const int K = g.K;
    unsigned voffA[2], voffB[2];
#pragma unroll
    for (int i = 0; i < 2; ++i) { int R, C; stage_rc(tid * 16 + i * 8192, R, C); const int Rb = Epi::PERM ? ((R & ~31) + perm32(R & 31)) : R;
        voffA[i] = (unsigned)(R * K + C) * 2u; voffB[i] = (unsigned)(Rb * K + C) * 2u; }
    const size_t kstep = (size_t)(BK * 2);
    const size_t hstep = (size_t)HALF * K * 2;
    const size_t tstep = 2 * hstep;
    const unsigned ldsw = (unsigned)wid * 1024u;
    const int aoff = lds_byte(wr * 64 + fr, fq * 8), boff = lds_byte(wc * 32 + fr, fq * 8);
#define PG8_SA(b, h) (((b) * 2 + (h)) * HTB)
#define PG8_SB(b, h) ((4 + (b) * 2 + (h)) * HTB)
#define PG8_STAGE(bufoff, gbase, voff) do { _Pragma("unroll") for (int _i = 0; _i < 2; ++_i) \
        __builtin_amdgcn_global_load_lds((const unsigned*)((const char*)(gbase) + (voff)[_i]), (LAS unsigned*)(lds + (bufoff) + ldsw + _i * 8192), 16, 0, 0); } while (0)
#define PG8_LDA(dst, b, h) do { _Pragma("unroll") for (int m = 0; m < 4; ++m) _Pragma("unroll") for (int k = 0; k < 2; ++k) dst[m][k] = *(const LAS bf16x8*)(lds + PG8_SA(b, h) + aoff + m * 2048 + k * 1024); } while (0)
#define PG8_LDB(dst, b, h) do { _Pragma("unroll") for (int n = 0; n < 2; ++n) _Pragma("unroll") for (int k = 0; k < 2; ++k) dst[n][k] = *(const LAS bf16x8*)(lds + PG8_SB(b, h) + boff + n * 2048 + k * 1024); } while (0)
#define PG8_MMA(ai, bj, At, Bt) do { __builtin_amdgcn_s_setprio(1); _Pragma("unroll") for (int m = 0; m < 4; ++m) _Pragma("unroll") for (int n = 0; n < 2; ++n) _Pragma("unroll") for (int k = 0; k < 2; ++k) \
        acc[ai][bj][m][n] = __builtin_amdgcn_mfma_f32_16x16x32_bf16(Bt[n][k], At[m][k], acc[ai][bj][m][n], 0, 0, 0); __builtin_amdgcn_s_setprio(0); } while (0)
#define PG8_WAIT_V(n) asm volatile("s_waitcnt vmcnt(" #n ")" ::: "memory")
#define PG8_WAIT_L(n) asm volatile("s_waitcnt lgkmcnt(" #n ")" ::: "memory")
#define PG8_BAR __builtin_amdgcn_s_barrier()
#define PG8_SCHED __builtin_amdgcn_sched_barrier(0)
    Unit cur, nxt; int ui = 0;
    if (!S.next(0, cur)) return;
    f32x4 acc[2][2][4][2];
#pragma unroll
    for (int a = 0; a < 2; ++a)
#pragma unroll
        for (int b = 0; b < 2; ++b)
#pragma unroll
            for (int m = 0; m < 4; ++m)
#pragma unroll
                for (int n = 0; n < 2; ++n) acc[a][b][m][n] = (f32x4){0.f, 0.f, 0.f, 0.f};
    bf16x8 At[4][2], B0[2][2], B1[2][2];
    const char* cA = (const char*)g.A + (size_t)cur.pm * tstep + (size_t)cur.kt0 * kstep; const char* cB = (const char*)g.Bt + (size_t)cur.pn * tstep + (size_t)cur.kt0 * kstep;
    PG8_STAGE(PG8_SB(0, 0), cB, voffB); PG8_STAGE(PG8_SB(0, 1), cB + hstep, voffB); PG8_STAGE(PG8_SA(0, 0), cA, voffA); PG8_STAGE(PG8_SA(0, 1), cA + hstep, voffA);
    if (wr == 1) PG8_BAR;
    PG8_WAIT_V(2); PG8_BAR;
    PG8_STAGE(PG8_SB(1, 0), cB + kstep, voffB); PG8_STAGE(PG8_SA(1, 0), cA + kstep, voffA); PG8_STAGE(PG8_SB(1, 1), cB + hstep + kstep, voffB);
    PG8_WAIT_V(6); PG8_BAR;
    for (;;) {
        const bool has_next = S.next(ui + 1, nxt);
        const char* nA = has_next ? (const char*)g.A + (size_t)nxt.pm * tstep + (size_t)nxt.kt0 * kstep : cA; const char* nB = has_next ? (const char*)g.Bt + (size_t)nxt.pn * tstep + (size_t)nxt.kt0 * kstep : cB;
        const int nt = cur.nt;
        for (int t = 0; t < nt; t += 2) {
            const bool last = (t == nt - 2);
            const char* a1 = cA + (size_t)(t + 1) * kstep;
            const char* a2 = last ? nA : cA + (size_t)(t + 2) * kstep; const char* b2 = last ? nB : cB + (size_t)(t + 2) * kstep;
            const char* a3 = a2 + kstep; const char* b3 = b2 + kstep;
            PG8_LDB(B0, 0, 0); PG8_LDB(B1, 0, 1); PG8_SCHED; PG8_LDA(At, 0, 0); PG8_STAGE(PG8_SA(1, 1), a1 + hstep, voffA);
            PG8_WAIT_V(8); PG8_WAIT_L(0); PG8_BAR; PG8_MMA(0, 0, At, B0); PG8_MMA(0, 1, At, B1); PG8_BAR; PG8_SCHED;
            PG8_LDA(At, 0, 1); PG8_STAGE(PG8_SB(0, 0), b2, voffB); PG8_STAGE(PG8_SB(0, 1), b2 + hstep, voffB); PG8_STAGE(PG8_SA(0, 0), a2, voffA);
            PG8_WAIT_V(8); PG8_WAIT_L(0); PG8_BAR; PG8_MMA(1, 0, At, B0); PG8_MMA(1, 1, At, B1); PG8_BAR; PG8_SCHED;
            PG8_LDB(B0, 1, 0); PG8_LDB(B1, 1, 1); PG8_SCHED; PG8_LDA(At, 1, 0); PG8_STAGE(PG8_SA(0, 1), a2 + hstep, voffA);
            PG8_WAIT_V(8); PG8_WAIT_L(0); PG8_BAR; PG8_MMA(0, 0, At, B0); PG8_MMA(0, 1, At, B1); PG8_BAR; PG8_SCHED;
            PG8_LDA(At, 1, 1); PG8_STAGE(PG8_SB(1, 0), b3, voffB); PG8_STAGE(PG8_SB(1, 1), b3 + hstep, voffB); PG8_STAGE(PG8_SA(1, 0), a3, voffA);
            PG8_WAIT_V(8); PG8_WAIT_L(0); PG8_BAR; PG8_MMA(1, 0, At, B0); PG8_MMA(1, 1, At, B1); PG8_BAR; PG8_SCHED;
        }
        if (wr == 0) PG8_BAR;
        E(acc, cur, wr, wc, fr, fq);
        if (!has_next) break;
#pragma unroll
        for (int a = 0; a < 2; ++a)
#pragma unroll
            for (int b = 0; b < 2; ++b)
#pragma unroll
                for (int m = 0; m < 4; ++m)
#pragma unroll
                    for (int n = 0; n < 2; ++n) acc[a][b][m][n] = (f32x4){0.f, 0.f, 0.f, 0.f};
        cur = nxt; cA = nA; cB = nB; ++ui;
        if (wr == 1) PG8_BAR;
    }
    PG8_WAIT_V(0);
    PG8_BAR;
#undef PG8_SA
#undef PG8_SB
#undef PG8_STAGE
#undef PG8_LDA
#undef PG8_LDB
#undef PG8_MMA
#undef PG8_WAIT_V
#undef PG8_WAIT_L
#undef PG8_BAR
#undef PG8_SCHED
}

struct EpiU {
    static constexpr bool PERM = true;
    bf16_t* O; int ldc;
    __device__ __forceinline__ void operator()(const f32x4 (&acc)[2][2][4][2], const Unit& u, int wr, int wc, int fr, int fq) const {
        const int row0 = u.pm * BM + wr * 64 + fr, col0 = u.pn * BM + wc * 32 + 8 * fq;
#pragma unroll
        for (int ai = 0; ai < 2; ++ai)
#pragma unroll
            for (int m = 0; m < 4; ++m) { bf16_t* rp = O + (size_t)(row0 + ai * HALF + m * 16) * ldc + col0;
#pragma unroll
                for (int bj = 0; bj < 2; ++bj) { const f32x4 v0 = acc[ai][bj][m][0], v1 = acc[ai][bj][m][1];
                    u32x4 w; w.x = cvt_pk_bf16(v0[0], v0[1]); w.y = cvt_pk_bf16(v0[2], v0[3]); w.z = cvt_pk_bf16(v1[0], v1[1]); w.w = cvt_pk_bf16(v1[2], v1[3]);
                    *(u32x4*)(rp + bj * HALF) = w; } }
    }
};
struct EpiRes {
    static constexpr bool PERM = false;
    const float* base_l; const float* base_c; float* out_l; float* out_c; const float* ada_l; int gi; int ntf; bool OUTB, BASEB;
    __device__ __forceinline__ void operator()(const f32x4 (&acc)[2][2][4][2], const Unit& u, int wr, int wc, int fr, int fq) const {
        const bool isc = u.pm >= 64;
        const int rb = isc ? (u.pm - 64) * BM : u.pm * BM;
        const float* base = isc ? base_c : base_l; float* out = isc ? out_c : out_l;
        const int bsel = isc ? 4 : (u.pm >> 4);
        const int row0 = rb + wr * 64 + fr, col0 = u.pn * BM + wc * 32 + 4 * fq;
        const float* gate = ada_l + (size_t)bsel * ADA_W + gi * DM + col0;
        f32x4 gv[2][2];
#pragma unroll
        for (int bj = 0; bj < 2; ++bj)
#pragma unroll
            for (int n = 0; n < 2; ++n) gv[bj][n] = *(const f32x4*)(gate + bj * HALF + n * 16);
        const bool split = (u.nt != ntf);
        if (split) {
            float* po = out + (size_t)(u.kt0 / u.nt) * ((size_t)MC * DM);
#pragma unroll
            for (int ai = 0; ai < 2; ++ai)
#pragma unroll
                for (int m = 0; m < 4; ++m) { const size_t off = (size_t)(row0 + ai * HALF + m * 16) * DM + col0;
#pragma unroll
                    for (int bj = 0; bj < 2; ++bj)
#pragma unroll
                        for (int n = 0; n < 2; ++n) *(f32x4*)(po + off + bj * HALF + n * 16) = gv[bj][n] * acc[ai][bj][m][n]; }
        } else {
            f32x4 bcur[4], bnxt[4];
            const bf16_t* baseb = (const bf16_t*)base; bf16_t* outb = (bf16_t*)out;
#define EPIRES_LD(dst, o_) do { if (BASEB) { const u32x2 w_ = *(const u32x2*)(baseb + (o_)); dst = (f32x4){lo16(w_.x), hi16(w_.x), lo16(w_.y), hi16(w_.y)}; } else dst = *(const f32x4*)(base + (o_)); } while (0)
#pragma unroll
            for (int bj = 0; bj < 2; ++bj)
#pragma unroll
                for (int n = 0; n < 2; ++n) EPIRES_LD(bcur[bj * 2 + n], (size_t)row0 * DM + col0 + bj * HALF + n * 16);
#pragma unroll
            for (int g8 = 0; g8 < 8; ++g8) { const int ai = g8 >> 2, m = g8 & 3;
                const size_t off = (size_t)(row0 + ai * HALF + m * 16) * DM + col0;
                if (g8 < 7) { const int ai2 = (g8 + 1) >> 2, m2 = (g8 + 1) & 3; const size_t off2 = (size_t)(row0 + ai2 * HALF + m2 * 16) * DM + col0;
#pragma unroll
                    for (int bj = 0; bj < 2; ++bj)
#pragma unroll
                        for (int n = 0; n < 2; ++n) EPIRES_LD(bnxt[bj * 2 + n], off2 + bj * HALF + n * 16); }
#pragma unroll
                for (int bj = 0; bj < 2; ++bj)
#pragma unroll
                    for (int n = 0; n < 2; ++n) { const f32x4 r_ = bcur[bj * 2 + n] + gv[bj][n] * acc[ai][bj][m][n];
                        if (OUTB) { u32x2 w_; w_.x = cvt_pk_bf16(r_[0], r_[1]); w_.y = cvt_pk_bf16(r_[2], r_[3]); *(u32x2*)(outb + off + bj * HALF + n * 16) = w_; }
                        else *(f32x4*)(out + off + bj * HALF + n * 16) = r_; }
#pragma unroll
                for (int k = 0; k < 4; ++k) bcur[k] = bnxt[k];
                __builtin_amdgcn_sched_barrier(0);
            }
#undef EPIRES_LD
        }
    }
};
struct EpiUp {
    static constexpr bool PERM = true;
    bf16_t* A2; float* EDGE; const float* cw; const float* cb;
    __device__ __forceinline__ void operator()(const f32x4 (&acc)[2][2][4][2], const Unit& u, int wr, int wc, int fr_, int fq_) const {
        const int lane_ = (int)__builtin_amdgcn_mbcnt_hi(~0u, __builtin_amdgcn_mbcnt_lo(~0u, (unsigned)opaque_s(0))); const int fr = lane_ & 15, fq = lane_ >> 4; (void)fr_; (void)fq_;
        const int ucol = u.pn * HALF + wc * 32;
        const GAS char* wb = (const GAS char*)(cw + ucol); const GAS char* bb = (const GAS char*)(cb + ucol);
        GAS char* a2g = (GAS char*)A2; GAS char* edg = (GAS char*)EDGE;
        const GAS char* pg0 = wb; const GAS char* pg1 = wb + FF2 * 4; const GAS char* pg2 = wb + 2 * FF2 * 4; const GAS char* pv0 = wb + FF * 4; const GAS char* pv1 = wb + (FF2 + FF) * 4; const GAS char* pv2 = wb + (2 * FF2 + FF) * 4;
        const GAS char* pbg = bb; const GAS char* pbv = bb + FF * 4;
        asm volatile("" : "+s"(pg0), "+s"(pg1), "+s"(pg2), "+s"(pv0), "+s"(pv1), "+s"(pv2), "+s"(pbg), "+s"(pbv));
        const unsigned lo = (unsigned)(32 * fq);
        const int rowb = u.pm * BM + wr * 64;
#pragma unroll
        for (int n = 0; n < 2; ++n) {
            const f32x4 wg0 = *(const GAS f32x4*)(pg0 + lo + n * 16), wg1 = *(const GAS f32x4*)(pg1 + lo + n * 16), wg2 = *(const GAS f32x4*)(pg2 + lo + n * 16), bg = *(const GAS f32x4*)(pbg + lo + n * 16);
            const f32x4 wv0 = *(const GAS f32x4*)(pv0 + lo + n * 16), wv1 = *(const GAS f32x4*)(pv1 + lo + n * 16), wv2 = *(const GAS f32x4*)(pv2 + lo + n * 16), bv = *(const GAS f32x4*)(pbv + lo + n * 16);
#pragma unroll
            for (int ai = 0; ai < 2; ++ai) {
                const unsigned rowoff = (unsigned)((rowb + ai * HALF + fr) * FF + ucol) * 2u + lo / 2u;
                float res[4][4];
#pragma unroll
                for (int j = 0; j < 4; ++j) {
                    float Gv[4], Vv[4], GR[4], GL[4], VR[4], VL[4];
#pragma unroll
                    for (int m = 0; m < 4; ++m) { Gv[m] = acc[ai][0][m][n][j]; Vv[m] = acc[ai][1][m][n][j];
                        GR[m] = dpp_ror1(Gv[m]); GL[m] = dpp_ror15(Gv[m]); VR[m] = dpp_ror1(Vv[m]); VL[m] = dpp_ror15(Vv[m]); }
#pragma unroll
                    for (int m = 0; m < 4; ++m) {
                        const float gp = (fr == 0) ? (m > 0 ? GR[m > 0 ? m - 1 : 0] : 0.f) : GR[m];
                        const float gn = (fr == 15) ? (m < 3 ? GL[m < 3 ? m + 1 : 3] : 0.f) : GL[m];
                        const float vp = (fr == 0) ? (m > 0 ? VR[m > 0 ? m - 1 : 0] : 0.f) : VR[m];
                        const float vn = (fr == 15) ? (m < 3 ? VL[m < 3 ? m + 1 : 3] : 0.f) : VL[m];
                        const float cgv = wg0[j] * gp + wg1[j] * Gv[m] + wg2[j] * gn + bg[j];
                        const float cvv = wv0[j] * vp + wv1[j] * Vv[m] + wv2[j] * vn + bv[j];
                        res[m][j] = siluf_(cgv) * cvv;
                    }
                    __builtin_amdgcn_sched_barrier(0);
                }
#pragma unroll
                for (int m = 0; m < 4; ++m) {
                    const int q = 16 * m + fr;
                    if (q >= 1 && q <= 62) {
                        u32x2 w; w.x = cvt_pk_bf16(res[m][0], res[m][1]); w.y = cvt_pk_bf16(res[m][2], res[m][3]);
                        *(GAS u32x2*)(a2g + (rowoff + (unsigned)(m * 16 * FF * 2 + n * 8))) = w;
                    }
                }
                __builtin_amdgcn_sched_barrier(0);
            }
        }
#pragma unroll
        for (int ai = 0; ai < 2; ++ai) {
            const int band = u.pm * 4 + wr + ai * 2;
            if (fr < 2) { const unsigned eo = (unsigned)((band * 4 + fr) * FF2 + ucol) * 4u + lo;
#pragma unroll
                for (int n = 0; n < 2; ++n) { *(GAS f32x4*)(edg + (eo + n * 16)) = acc[ai][0][0][n]; *(GAS f32x4*)(edg + (eo + FF * 4 + n * 16)) = acc[ai][1][0][n]; } }
            if (fr >= 14) { const unsigned eo = (unsigned)((band * 4 + fr - 12) * FF2 + ucol) * 4u + lo;
#pragma unroll
                for (int n = 0; n < 2; ++n) { *(GAS f32x4*)(edg + (eo + n * 16)) = acc[ai][0][3][n]; *(GAS f32x4*)(edg + (eo + FF * 4 + n * 16)) = acc[ai][1][3][n]; } }
        }
    }
};
}

__device__ __forceinline__ void transpose_item(const float* W, int K, int N, bf16_t* WT, int up_remap, float* scr, int item, int lane) {
    const int nblk = N / 64, kb = item / nblk, nb = item % nblk, k0 = 64 * kb, n0 = 64 * nb;
    const int kr = lane >> 4, c4 = lane & 15;
    f32x4 t[16];
#pragma unroll
    for (int i = 0; i < 16; ++i) t[i] = *(const f32x4*)(W + (size_t)(k0 + 4 * i + kr) * N + n0 + 4 * c4);
#pragma unroll
    for (int i = 0; i < 16; ++i) { float* sp = scr + (4 * i + kr) * 65 + 4 * c4; sp[0] = t[i][0]; sp[1] = t[i][1]; sp[2] = t[i][2]; sp[3] = t[i][3]; }
    asm volatile("s_waitcnt lgkmcnt(0)" ::: "memory");
    int rown0 = n0;
    if (up_remap) rown0 = n0 < FF ? (n0 / 128) * 256 + (n0 % 128) : ((n0 - FF) / 128) * 256 + 128 + ((n0 - FF) % 128);
    const int c = lane & 7;
#pragma unroll
    for (int j = 0; j < 8; ++j) { const int n = (lane >> 3) + 8 * j; const float* s = scr + (8 * c) * 65 + n;
        u32x4 o; o.x = pk2(s[0 * 65], s[1 * 65]); o.y = pk2(s[2 * 65], s[3 * 65]); o.z = pk2(s[4 * 65], s[5 * 65]); o.w = pk2(s[6 * 65], s[7 * 65]);
        *(u32x4*)(WT + (size_t)(rown0 + n) * K + k0 + 8 * c) = o; }
    asm volatile("s_waitcnt lgkmcnt(0)" ::: "memory");
}

__device__ __forceinline__ void phase0(const Params& P, unsigned char* lds, int tid, int lane, int wave, int bid, int G) {
    float* ada = (float*)(P.ws + WS_ADA);
    float* sc = (float*)lds; float* red = (float*)(lds + 40960);
    for (int item = bid; item < 192; item += G) {
        const int l = item / 96, n0 = (item % 96) * 128;
        for (int i = tid; i < 5 * DM; i += 512) { const int r = i >> 11, k = i & 2047; const float v = r < 4 ? P.c[r * DM + k] : P.c_ctx[k]; sc[i] = siluf_(v); }
        __syncthreads();
        const int c4 = tid & 31, kp = tid >> 5;
        f32x4 a0 = {0, 0, 0, 0}, a1 = a0, a2 = a0, a3 = a0, a4 = a0;
        const float* wp = P.w_ada + ((size_t)l * DM + kp * 128) * ADA_W + n0 + c4 * 4;
        const float* sp = sc + kp * 128;
#pragma unroll 8
        for (int kk = 0; kk < 128; ++kk) { const f32x4 w = *(const f32x4*)(wp + (size_t)kk * ADA_W);
            a0 += sp[kk] * w; a1 += sp[DM + kk] * w; a2 += sp[2 * DM + kk] * w; a3 += sp[3 * DM + kk] * w; a4 += sp[4 * DM + kk] * w; }
        *(f32x4*)(red + (kp * 5 + 0) * 128 + c4 * 4) = a0; *(f32x4*)(red + (kp * 5 + 1) * 128 + c4 * 4) = a1; *(f32x4*)(red + (kp * 5 + 2) * 128 + c4 * 4) = a2;
        *(f32x4*)(red + (kp * 5 + 3) * 128 + c4 * 4) = a3; *(f32x4*)(red + (kp * 5 + 4) * 128 + c4 * 4) = a4;
        __syncthreads();
        for (int o = tid; o < 640; o += 512) { const int r = o >> 7, col = o & 127; float s = 0.f;
#pragma unroll
            for (int k2 = 0; k2 < 16; ++k2) s += red[(k2 * 5 + r) * 128 + col];
            ada[(size_t)(l * 5 + r) * ADA_W + n0 + col] = s + P.b_ada[l * ADA_W + n0 + col]; }
        __syncthreads();
    }
    __syncthreads();
    float* scr = (float*)(lds + wave * 16896);
    const int gw = bid * 8 + wave, NGW = G * 8;
    constexpr int I_IN = 32 * 112, I_OUT = 32 * 32, I_UP = 32 * 176, I_DN = 88 * 32, I_L = I_IN + I_OUT + I_UP + I_DN;
    for (int it = gw; it < 2 * I_L; it += NGW) {
        const int l = it / I_L; int r = it % I_L;
        bf16_t* wt = (bf16_t*)(P.ws + WS_WT + (size_t)l * WT_LAYER);
        if (r < I_IN) { transpose_item(P.w_in + (size_t)l * DM * INW, DM, INW, wt, 0, scr, r, lane); continue; } r -= I_IN;
        if (r < I_OUT) { transpose_item(P.w_out + (size_t)l * DM * DM, DM, DM, (bf16_t*)((unsigned char*)wt + WT_OUT_OFF), 0, scr, r, lane); continue; } r -= I_OUT;
        if (r < I_UP) { transpose_item(P.w_up + (size_t)l * DM * FF2, DM, FF2, (bf16_t*)((unsigned char*)wt + WT_UP_OFF), 1, scr, r, lane); continue; } r -= I_UP;
        transpose_item(P.w_down + (size_t)l * FF * DM, FF, DM, (bf16_t*)((unsigned char*)wt + WT_DN_OFF), 0, scr, r, lane);
    }
}

__device__ __forceinline__ void phase_norm(bool XLB, const float* xl, const float* xc, const float* part, const float* lnw, const float* ada_l, int sh_idx, int nrows, bf16_t* HA, float* copy_c, int gw, int NGW, int lane) {
    for (int m0 = gw * 2; m0 < nrows; m0 += NGW * 2) {
        const int bsel = m0 < ML ? (m0 >> 12) : 4;
        const float* sh = ada_l + (size_t)bsel * ADA_W + sh_idx * DM; const float* scl = sh + DM;
        f32x4 v[2][8]; float ss[2] = {0.f, 0.f};
#pragma unroll
        for (int r = 0; r < 2; ++r) {
            if (XLB && m0 < ML) { const bf16_t* xb = (const bf16_t*)xl + (size_t)(m0 + r) * DM;
#pragma unroll
                for (int j = 0; j < 8; ++j) { const u32x2 w_ = *(const u32x2*)(xb + 256 * j + 4 * lane); v[r][j] = (f32x4){lo16(w_.x), hi16(w_.x), lo16(w_.y), hi16(w_.y)}; } }
            else { const float* xr = rowp(xl, xc, m0 + r);
#pragma unroll
                for (int j = 0; j < 8; ++j) v[r][j] = *(const f32x4*)(xr + 256 * j + 4 * lane); } }
        if (part && m0 >= ML) {
#pragma unroll
            for (int ks = 0; ks < 4; ++ks)
#pragma unroll
                for (int r = 0; r < 2; ++r)
#pragma unroll
                    for (int j = 0; j < 8; ++j) v[r][j] += *(const f32x4*)(part + (size_t)ks * ((size_t)MC * DM) + (size_t)(m0 - ML + r) * DM + 256 * j + 4 * lane); }
        if (copy_c && m0 >= ML) {
#pragma unroll
            for (int r = 0; r < 2; ++r)
#pragma unroll
                for (int j = 0; j < 8; ++j) *(f32x4*)(copy_c + (size_t)(m0 - ML + r) * DM + 256 * j + 4 * lane) = v[r][j]; }
#pragma unroll
        for (int r = 0; r < 2; ++r) {
#pragma unroll
            for (int j = 0; j < 8; ++j) ss[r] += v[r][j][0] * v[r][j][0] + v[r][j][1] * v[r][j][1] + v[r][j][2] * v[r][j][2] + v[r][j][3] * v[r][j][3];
            ss[r] = wave_sum(ss[r], lane); }
        const float rstd0 = rsqrtf(ss[0] * (1.f / DM) + EPS), rstd1 = rsqrtf(ss[1] * (1.f / DM) + EPS);
        bf16_t* orow = HA + (size_t)m0 * DM;
#pragma unroll
        for (int j = 0; j < 8; ++j) { const int col = 256 * j + 4 * lane;
            const f32x4 w = *(const f32x4*)(lnw + col), s = *(const f32x4*)(sh + col), c = *(const f32x4*)(scl + col);
            const f32x4 h0 = (v[0][j] * rstd0 * w) * (1.f + c) + s, h1 = (v[1][j] * rstd1 * w) * (1.f + c) + s;
            u32x2 o0, o1; o0.x = pk2(h0[0], h0[1]); o0.y = pk2(h0[2], h0[3]); o1.x = pk2(h1[0], h1[1]); o1.y = pk2(h1[2], h1[3]);
            *(u32x2*)(orow + col) = o0; *(u32x2*)(orow + DM + col) = o1; }
    }
}

__device__ __forceinline__ void hg_gates(const bf16_t* U, int base, int step, int zcol, float lbv, int pq, float (&lc)[16], float (&kk)[16]) {
    float run = 0.f;
#pragma unroll
    for (int i = 0; i < 16; ++i) { const int row = base + step * (pq * 16 + i);
        const float z = bf2f(U[(unsigned)(row * INW + zcol)]);
        const float e = __expf(-z), sg = rcpf_(1.f + e);
        const float f = lbv + (1.f - lbv) * sg;
        run += __logf(fmaxf(f, 1e-30f)); lc[i] = run; kk[i] = (1.f - lbv) * e * sg; }
}
__device__ __forceinline__ void hg_chunk_rows(int b, int dir, int c, int& base, int& step) {
    if (c < 4) base = ML + b * CTXL + (dir ? 255 - 64 * c : 64 * c);
    else base = b * SEQ + (dir ? 4095 - 64 * (c - 4) : 64 * (c - 4));
    step = dir ? -1 : 1;
}
__device__ __forceinline__ float hg_lb(const Params& P, int l, int dir, int idx) {
    if (l == 0) return 0.f;
    const float x0 = P.hg_lb[(dir * 2 + 0) * 512 + idx], x1 = P.hg_lb[(dir * 2 + 1) * 512 + idx];
    return rcpf_(1.f + __expf(x0 - x1));
}

__device__ __forceinline__ void hg_local_item(const Params& P, int l, const bf16_t* U, int item, unsigned char* lds, int tid) {
    const int s = item / NCHUNK, c = item % NCHUNK, dir = s & 1, h = (s >> 1) & 3, b = s >> 3;
    int base, step; hg_chunk_rows(b, dir, c, base, step);
    const int d = tid & 127, pq = tid >> 7, lane = tid & 63, wave = tid >> 6, fr = lane & 15, fq = lane >> 4;
    bf16_t* KT = (bf16_t*)lds; bf16_t* VT = (bf16_t*)(lds + 18432); float* PART = (float*)(lds + 36864);
    float* LT = (float*)(P.ws + WS_X1) + (size_t)item * 16384; float* DC = (float*)(P.ws + WS_DC) + (size_t)item * 128;
    const float lbv = hg_lb(P, l, dir, h * 128 + d);
    float lc[16], kk[16];
    bf16_t vraw[16];
#pragma unroll
    for (int i = 0; i < 16; ++i) vraw[i] = U[(unsigned)((base + step * (pq * 16 + i)) * INW + C_IV + h * 128 + d)];
    hg_gates(U, base, step, dir * 512 + h * 128 + d, lbv, pq, lc, kk);
    PART[pq * 128 + d] = lc[15];
    __syncthreads();
    const float p0 = PART[d], p1 = PART[128 + d], p2 = PART[256 + d], p3 = PART[384 + d];
    const float tot = p0 + p1 + p2 + p3;
    const float pre = pq == 0 ? 0.f : (pq == 1 ? p0 : (pq == 2 ? p0 + p1 : p0 + p1 + p2));
#pragma unroll
    for (int i = 0; i < 16; ++i) { const int pos = pq * 16 + i;
        KT[d * 72 + pos] = (bf16_t)f2bf(kk[i] * __expf(tot - (pre + lc[i])));
        VT[d * 72 + pos] = vraw[i]; }
    if (pq == 0) DC[d] = __expf(tot);
    __syncthreads();
    const int er = 16 * wave + fr;
    bf16x8 af[2];
#pragma unroll
    for (int ks = 0; ks < 2; ++ks) af[ks] = *(const bf16x8*)(VT + er * 72 + ks * 32 + fq * 8);
#pragma unroll
    for (int nt = 0; nt < 8; ++nt) { f32x4 acc = {0.f, 0.f, 0.f, 0.f};
#pragma unroll
        for (int ks = 0; ks < 2; ++ks) { const bf16x8 bfr = *(const bf16x8*)(KT + (16 * nt + fr) * 72 + ks * 32 + fq * 8); acc = MFMA16(af[ks], bfr, acc); }
#pragma unroll
        for (int j = 0; j < 4; ++j) LT[(16 * wave + fq * 4 + j) * 128 + 16 * nt + fr] = acc[j]; }
    __syncthreads();
}

__device__ __forceinline__ void hg_local_raw(const bf16_t* U, int item, int d, int pq, bf16_t (&zr)[16], bf16_t (&vr)[16]) {
    const int s = item / NCHUNK, c = item % NCHUNK, dir = s & 1, h = (s >> 1) & 3, b = s >> 3;
    int base, step; hg_chunk_rows(b, dir, c, base, step);
#pragma unroll
    for (int i = 0; i < 16; ++i) { const unsigned ro = (unsigned)((base + step * (pq * 16 + i)) * INW + h * 128 + d); zr[i] = U[ro + dir * 512]; vr[i] = U[ro + C_IV]; }
}
__device__ __forceinline__ void hg_local_static(const Params& P, int l, const bf16_t* U, int nitems, int bid, int G, unsigned char* lds, int tid) {
    const int d = tid & 127, pq = tid >> 7, lane = tid & 63, wave = tid >> 6, fr = lane & 15, fq = lane >> 4;
    bf16_t* KT = (bf16_t*)lds; bf16_t* VT = (bf16_t*)(lds + 18432); float* PART = (float*)(lds + 36864);
    bf16_t zr[16], vr[16];
    int item = bid;
    if (item < nitems) hg_local_raw(U, item, d, pq, zr, vr);
#pragma unroll 1
    while (item < nitems) {
        const int s = item / NCHUNK, dir = s & 1, h = (s >> 1) & 3;
        float* LT = (float*)(P.ws + WS_X1) + (size_t)item * 16384; float* DC = (float*)(P.ws + WS_DC) + (size_t)item * 128;
        const float lbv = hg_lb(P, l, dir, h * 128 + d);
        float lc[16], kk[16]; float run = 0.f;
#pragma unroll
        for (int i = 0; i < 16; ++i) { const float z = bf2f(zr[i]);
            const float e = __expf(-z), sg = rcpf_(1.f + e);
            const float f = lbv + (1.f - lbv) * sg;
            run += __logf(fmaxf(f, 1e-30f)); lc[i] = run; kk[i] = (1.f - lbv) * e * sg; }
        PART[pq * 128 + d] = run;
        __syncthreads();
        const float p0 = PART[d], p1 = PART[128 + d], p2 = PART[256 + d], p3 = PART[384 + d];
        const float tot = p0 + p1 + p2 + p3;
        const float pre = pq == 0 ? 0.f : (pq == 1 ? p0 : (pq == 2 ? p0 + p1 : p0 + p1 + p2));
#pragma unroll
        for (int i = 0; i < 16; ++i) { const int pos = pq * 16 + i;
            KT[d * 72 + pos] = (bf16_t)f2bf(kk[i] * __expf(tot - (pre + lc[i])));
            VT[d * 72 + pos] = vr[i]; }
        if (pq == 0) DC[d] = __expf(tot);
        const int nitem = item + G;
        if (nitem < nitems) hg_local_raw(U, nitem, d, pq, zr, vr);
        __syncthreads();
        const int er = 16 * wave + fr;
        bf16x8 af[2];
#pragma unroll
        for (int ks = 0; ks < 2; ++ks) af[ks] = *(const bf16x8*)(VT + er * 72 + ks * 32 + fq * 8);
#pragma unroll
        for (int nt = 0; nt < 8; ++nt) { f32x4 acc = {0.f, 0.f, 0.f, 0.f};
#pragma unroll
            for (int ks = 0; ks < 2; ++ks) { const bf16x8 bfr = *(const bf16x8*)(KT + (16 * nt + fr) * 72 + ks * 32 + fq * 8); acc = MFMA16(af[ks], bfr, acc); }
#pragma unroll
            for (int j = 0; j < 4; ++j) LT[(16 * wave + fq * 4 + j) * 128 + 16 * nt + fr] = acc[j]; }
        __syncthreads();
        item = nitem;
    }
}

__device__ __forceinline__ void hg_scan(const Params& P, int tid, int bid, int G) {
    const float* LT = (const float*)(P.ws + WS_X1); const float* DC = (const float*)(P.ws + WS_DC); bf16_t* ST = (bf16_t*)(P.ws + WS_HA);
    for (int idx = bid * 512 + tid; idx < 32 * 4096; idx += G * 512) {
        const int s = idx >> 12, off4 = idx & 4095, d4 = off4 & 31;
        f32x4 S = {0.f, 0.f, 0.f, 0.f};
        const float* Lp = LT + (size_t)s * NCHUNK * 16384 + off4 * 4; const float* Dp = DC + (size_t)s * NCHUNK * 128 + d4 * 4;
        bf16_t* Sp = ST + (size_t)s * NCHUNK * 16384 + off4 * 4;
        f32x4 Lc[8], Dc[8], Ln[8], Dn[8];
#pragma unroll
        for (int k = 0; k < 8; ++k) { Lc[k] = *(const f32x4*)(Lp + (size_t)k * 16384); Dc[k] = *(const f32x4*)(Dp + k * 128); }
#pragma unroll 1
        for (int c0 = 0; c0 < NCHUNK; c0 += 8) {
#pragma unroll
            for (int k = 0; k < 8; ++k) if (c0 + 8 + k < NCHUNK) { Ln[k] = *(const f32x4*)(Lp + (size_t)(c0 + 8 + k) * 16384); Dn[k] = *(const f32x4*)(Dp + (c0 + 8 + k) * 128); }
#pragma unroll
            for (int k = 0; k < 8; ++k) if (c0 + k < NCHUNK) { u32x2 o; o.x = pk2(S[0], S[1]); o.y = pk2(S[2], S[3]);
                *(u32x2*)(Sp + (size_t)(c0 + k) * 16384) = o;
                S = Dc[k] * S + Lc[k]; }
#pragma unroll
            for (int k = 0; k < 8; ++k) { Lc[k] = Ln[k]; Dc[k] = Dn[k]; }
        }
    }
}

__device__ __forceinline__ void hg_out_item(const Params& P, int l, const bf16_t* U, bf16_t* MIX, int b, int h, int pc, unsigned char* lds, int tid) {
    const int d = tid & 127, pq = tid >> 7, lane = tid & 63, wave = tid >> 6, fr = lane & 15, fq = lane >> 4;
    bf16_t* QT = (bf16_t*)lds; bf16_t* QH = (bf16_t*)(lds + 17408); bf16_t* KH = (bf16_t*)(lds + 34816); bf16_t* VT = (bf16_t*)(lds + 78336);
    bf16_t* ATT = (bf16_t*)(lds + 96768); float* OS = (float*)(lds + 105984); float* PART = (float*)(lds + 139776);
    const bf16_t* ST = (const bf16_t*)(P.ws + WS_HA);
#pragma unroll 1
    for (int dir = 0; dir < 2; ++dir) {
        const int c = dir == 0 ? pc : (pc < 4 ? 3 - pc : 71 - pc);
        int base, step; hg_chunk_rows(b, dir, c, base, step);
        const size_t item = (size_t)((b * 4 + h) * 2 + dir) * NCHUNK + c;
        const float lbv = hg_lb(P, l, dir, h * 128 + d);
        float lc[16], kk[16];
        bf16x8 stf[4][4];
        { const bf16_t* STc = ST + item * 16384; const int ntb0 = (wave >> 2) * 4;
#pragma unroll
          for (int ks = 0; ks < 4; ++ks)
#pragma unroll
              for (int t = 0; t < 4; ++t) stf[ks][t] = *(const bf16x8*)(STc + (16 * (ntb0 + t) + fr) * 128 + ks * 32 + fq * 8); }
        bf16_t vraw[16], qraw[16];
#pragma unroll
        for (int i = 0; i < 16; ++i) { const unsigned ro = (unsigned)((base + step * (pq * 16 + i)) * INW + h * 128 + d); vraw[i] = U[ro + C_IV]; qraw[i] = U[ro + C_HGQ]; }
        hg_gates(U, base, step, dir * 512 + h * 128 + d, lbv, pq, lc, kk);
        PART[pq * 128 + d] = lc[15];
        __syncthreads();
        const float p0 = PART[d], p1 = PART[128 + d], p2 = PART[256 + d];
        const float ref1 = p0, ref2 = p0 + p1, ref3 = p0 + p1 + p2;
        const float myref = pq == 0 ? 0.f : (pq == 1 ? ref1 : (pq == 2 ? ref2 : ref3));
        const float gref = __expf(myref);
        float fI[4];
#pragma unroll
        for (int I = 0; I < 4; ++I) { const float refI = I == 0 ? 0.f : (I == 1 ? ref1 : (I == 2 ? ref2 : ref3)); fI[I] = __expf(fminf(refI - myref, 0.f)); }
#pragma unroll
        for (int i = 0; i < 16; ++i) { const int pos = pq * 16 + i;
            const float qv = siluf_(bf2f(qraw[i]));
            const float el = __expf(lc[i]), eln = __expf(fminf(-lc[i], 80.f));
            const float qh = qv * el, kh = kk[i] * eln;
            QT[pos * 136 + d] = (bf16_t)f2bf(qh * gref);
            QH[pos * 136 + d] = (bf16_t)f2bf(qh);
#pragma unroll
            for (int I = 0; I < 4; ++I) if (I >= pq) KH[(8 * I * (I + 1) + pos) * 136 + d] = (bf16_t)f2bf(kh * fI[I]);
            VT[d * 72 + pos] = vraw[i]; }
        __syncthreads();
        const int I = wave & 3, half = wave >> 2;
        {
            bf16x8 aq[4];
#pragma unroll
            for (int ks = 0; ks < 4; ++ks) aq[ks] = *(const bf16x8*)(QH + (16 * I + fr) * 136 + ks * 32 + fq * 8);
#pragma unroll
            for (int jj = 0; jj < 2; ++jj) { const int J = half + 2 * jj;
                f32x4 acc = {0.f, 0.f, 0.f, 0.f};
                if (J <= I) {
#pragma unroll
                    for (int ks = 0; ks < 4; ++ks) { const bf16x8 bk = *(const bf16x8*)(KH + (8 * I * (I + 1) + 16 * J + fr) * 136 + ks * 32 + fq * 8); acc = MFMA16(aq[ks], bk, acc); }
                }
#pragma unroll
                for (int j = 0; j < 4; ++j) { const int ii = 16 * I + fq * 4 + j, jc = 16 * J + fr;
                    const float v = (J <= I && jc <= ii) ? acc[j] : 0.f;
                    ATT[ii * 72 + jc] = (bf16_t)f2bf(v); } }
        }
        __syncthreads();
        {
            f32x4 o[4];
#pragma unroll
            for (int t = 0; t < 4; ++t) o[t] = (f32x4){0.f, 0.f, 0.f, 0.f};
            const int ntb = half * 4;
#pragma unroll
            for (int ks = 0; ks < 4; ++ks) { const bf16x8 a = *(const bf16x8*)(QT + (16 * I + fr) * 136 + ks * 32 + fq * 8);
#pragma unroll
                for (int t = 0; t < 4; ++t) o[t] = MFMA16(a, stf[ks][t], o[t]); }
            const int nks = (I + 2) >> 1;
#pragma unroll
            for (int ks = 0; ks < 2; ++ks) if (ks < nks) { const bf16x8 a = *(const bf16x8*)(ATT + (16 * I + fr) * 72 + ks * 32 + fq * 8);
#pragma unroll
                for (int t = 0; t < 4; ++t) { const bf16x8 bv = *(const bf16x8*)(VT + (16 * (ntb + t) + fr) * 72 + ks * 32 + fq * 8); o[t] = MFMA16(a, bv, o[t]); } }
#pragma unroll
            for (int t = 0; t < 4; ++t)
#pragma unroll
                for (int j = 0; j < 4; ++j) { const int ii = 16 * I + fq * 4 + j, pl = dir ? 63 - ii : ii, e = 16 * (ntb + t) + fr;
                    if (dir == 0) OS[pl * 132 + e] = o[t][j]; else OS[pl * 132 + e] += o[t][j]; }
        }
        __syncthreads();
    }
    const int rowbase = pc < 4 ? ML + b * CTXL + 64 * pc : b * SEQ + 64 * (pc - 4);
    const float w0 = P.hg_norm_w[l * 128 + 2 * lane], w1 = P.hg_norm_w[l * 128 + 2 * lane + 1];
#pragma unroll 2
    for (int i = 0; i < 8; ++i) { const int pl = wave * 8 + i, row = rowbase + pl;
        const float o0 = OS[pl * 132 + 2 * lane], o1 = OS[pl * 132 + 2 * lane + 1];
        const float ss = wave_sum(o0 * o0 + o1 * o1, lane);
        const float rstd = rsqrtf(ss * (1.f / 128.f) + EPS);
        const unsigned gw2 = *(const unsigned*)(U + (unsigned)(row * INW + C_HGG + h * 128 + 2 * lane));
        const float g0 = lo16(gw2), g1 = hi16(gw2);
        *(unsigned*)(MIX + (size_t)row * DM + h * 128 + 2 * lane) = pk2(o0 * rstd * w0 * siluf_(g0), o1 * rstd * w1 * siluf_(g1)); }
    __syncthreads();
}

__device__ __forceinline__ void na_item(const Params& P, int l, const bf16_t* U, bf16_t* MIX, int qrow0, int b, int r0, int hp, bool local, unsigned char* lds, int tid) {
    const int lane = tid & 63, wave = tid >> 6, hh = wave >> 2, qb = wave & 3, h = hp * 2 + hh, fr = lane & 15, fq = lane >> 4;
    bf16_t* Kt = (bf16_t*)lds + hh * (64 * 136);
    bf16_t* Vn = (bf16_t*)(lds + 34816) + hh * (64 * 144);
    bf16_t* Pw = (bf16_t*)(lds + 71680) + wave * (32 * 72);
    float* RPB = (float*)(lds + 108544);
    float* KS = (float*)(lds + 112640) + hh * 64;
    const int rsA = min(max(r0 - 4, 0), 56), rsB = min(max(r0 - 3, 0), 56);
    const int nloc = local ? 8 + (rsB - rsA) : 0, ntile = nloc + 4;
    if (local) for (int i = tid; i < 2 * 465; i += 512) { const int h2 = i / 465, k = i % 465; RPB[h2 * 480 + k] = P.rpb[(size_t)((l * 8 + hp * 2 + h2) * 465) + k]; }
    const int tg = tid & 255;
    u32x4 kraw[4], vraw[4];
#define NA_LOAD(KT) do { _Pragma("unroll") for (int i = 0; i < 4; ++i) { const int pid = tg + 256 * i, key = pid >> 4, pc = pid & 15; \
        const int krow = (KT) < nloc ? b * SEQ + (rsA + (KT)) * 64 + key : ML + b * CTXL + ((KT) - nloc) * 64 + key; \
        const bf16_t* up = U + (unsigned)(krow * INW + h * 128 + pc * 8); kraw[i] = *(const u32x4*)(up + C_NAK); vraw[i] = *(const u32x4*)(up + C_NAV); } } while (0)
    NA_LOAD(0);
    bf16x8 qf[2][4];
    {
        const float* qw = P.q_norm_w + l * 128; const float* kw = P.k_norm_w + l * 128;
#pragma unroll
        for (int q2 = 0; q2 < 2; ++q2) {
            const bf16_t* qp = U + (unsigned)((qrow0 + q2 * 64 + qb * 16 + fr) * INW + C_NAQ + h * 128 + fq * 8);
            float qv[4][8]; float ss = 0.f;
#pragma unroll
            for (int ks = 0; ks < 4; ++ks) { unpack8(*(const u32x4*)(qp + ks * 32), qv[ks]);
#pragma unroll
                for (int e = 0; e < 8; ++e) ss += qv[ks][e] * qv[ks][e]; }
            ss += xshfl(ss, 16, lane); ss += xshfl(ss, 32, lane);
            const float rstd = rsqrtf(ss * (1.f / 128.f) + EPS) * ATTN_SCALE;
#pragma unroll
            for (int ks = 0; ks < 4; ++ks) { const int d0 = ks * 32 + fq * 8; float t[8];
#pragma unroll
                for (int e = 0; e < 8; ++e) t[e] = qv[ks][e] * rstd * qw[d0 + e] * kw[d0 + e];
                u32x4 w; w.x = pk2(t[0], t[1]); w.y = pk2(t[2], t[3]); w.z = pk2(t[4], t[5]); w.w = pk2(t[6], t[7]);
                qf[q2][ks] = as_frag(w); }
        }
    }
    f32x4 O[2][8];
    float mrow[2][4], lrow[2][4];
#pragma unroll
    for (int q2 = 0; q2 < 2; ++q2) {
#pragma unroll
        for (int nt = 0; nt < 8; ++nt) O[q2][nt] = (f32x4){0.f, 0.f, 0.f, 0.f};
#pragma unroll
        for (int j = 0; j < 4; ++j) { mrow[q2][j] = -3e38f; lrow[q2][j] = 0.f; } }
    const LAS bf16_t* vtr = (const LAS bf16_t*)Vn + (8 * fq + (fr >> 2)) * 144 + 4 * (fr & 3);
#pragma unroll 1
    for (int kt = 0; kt < ntile; ++kt) {
#pragma unroll
        for (int i = 0; i < 4; ++i) { const int pid = tg + 256 * i, key = pid >> 4, pc = pid & 15;
            float kf[8]; unpack8(kraw[i], kf); float ss = 0.f;
#pragma unroll
            for (int e = 0; e < 8; ++e) ss += kf[e] * kf[e];
            ss = sum16d(ss);
            if (pc == 0) KS[key] = rsqrtf(ss * (1.f / 128.f) + EPS);
            *(u32x4*)(Kt + key * 136 + pc * 8) = kraw[i];
            *(u32x4*)(Vn + key * 144 + pc * 8) = vraw[i]; }
        __syncthreads();
        if (kt + 1 < ntile) NA_LOAD(kt + 1);
        const bool isloc = kt < nloc;
        const int kr = rsA + kt;
        const bool val0 = !isloc || (kr < rsA + 8), val1 = !isloc || (kr >= rsB);
        f32x4 s[2][4];
#pragma unroll
        for (int nt = 0; nt < 4; ++nt) { s[0][nt] = (f32x4){0.f, 0.f, 0.f, 0.f}; s[1][nt] = (f32x4){0.f, 0.f, 0.f, 0.f};
            if (!isloc || (nt >= qb - 1 && nt <= qb + 1)) {
#pragma unroll
            for (int ks = 0; ks < 4; ++ks) { const bf16x8 bk = *(const bf16x8*)(Kt + (16 * nt + fr) * 136 + ks * 32 + fq * 8);
                if (val0) s[0][nt] = MFMA16(qf[0][ks], bk, s[0][nt]);
                if (val1) s[1][nt] = MFMA16(qf[1][ks], bk, s[1][nt]); }
            const float kscale = KS[16 * nt + fr];
#pragma unroll
            for (int j = 0; j < 4; ++j) { s[0][nt][j] *= kscale; s[1][nt][j] *= kscale; } } }
#pragma unroll
        for (int q2 = 0; q2 < 2; ++q2) {
            const bool val = q2 ? val1 : val0;
            if (val) {
                if (isloc) {
                    const int ir = kr - (r0 + q2) + 7;
#pragma unroll
                    for (int nt = 0; nt < 4; ++nt) {
                        if (nt >= qb - 1 && nt <= qb + 1) {
#pragma unroll
                        for (int j = 0; j < 4; ++j) { const int xq = qb * 16 + fq * 4 + j, kc = nt * 16 + fr;
                            const int wsx = min(max(xq - 8, 0), 48);
                            const bool ok = (kc >= wsx) && (kc < wsx + 16);
                            const int ic = min(max(kc - xq + 15, 0), 30);
                            s[q2][nt][j] = ok ? s[q2][nt][j] + RPB[hh * 480 + ir * 31 + ic] : -1e30f; }
                        } else s[q2][nt] = (f32x4){-1e30f, -1e30f, -1e30f, -1e30f}; }
                }
                float mxj[4]; bool need = false;
#pragma unroll
                for (int j = 0; j < 4; ++j) { float mx = fmaxf(fmaxf(s[q2][0][j], s[q2][1][j]), fmaxf(s[q2][2][j], s[q2][3][j])); mxj[j] = max16d(mx); need = need || (mxj[j] > mrow[q2][j] + 8.f); }
                if (__builtin_amdgcn_ballot_w64(need) != 0ull) {
                    float alpha[4];
#pragma unroll
                    for (int j = 0; j < 4; ++j) { const bool up = mxj[j] > mrow[q2][j] + 8.f; alpha[j] = up ? __expf(mrow[q2][j] - mxj[j]) : 1.f; mrow[q2][j] = up ? mxj[j] : mrow[q2][j]; lrow[q2][j] *= alpha[j]; }
#pragma unroll
                    for (int nt = 0; nt < 8; ++nt)
#pragma unroll
                        for (int j = 0; j < 4; ++j) O[q2][nt][j] *= alpha[j];
                }
#pragma unroll
                for (int j = 0; j < 4; ++j) { const float mn = mrow[q2][j]; float rsum = 0.f;
#pragma unroll
                    for (int nt = 0; nt < 4; ++nt) { const float pv = s[q2][nt][j] > -1e29f ? __expf(s[q2][nt][j] - mn) : 0.f; s[q2][nt][j] = pv; rsum += pv; }
                    rsum = sum16d(rsum); lrow[q2][j] += rsum; }
#pragma unroll
                for (int nt = 0; nt < 4; ++nt)
#pragma unroll
                    for (int j = 0; j < 4; ++j) Pw[(q2 * 16 + fq * 4 + j) * 72 + nt * 16 + fr] = (bf16_t)f2bf(s[q2][nt][j]);
            }
        }
        asm volatile("s_waitcnt lgkmcnt(0)" ::: "memory");
#pragma unroll
        for (int ks = 0; ks < 2; ++ks) { const bf16x8 a0 = *(const bf16x8*)(Pw + fr * 72 + ks * 32 + fq * 8), a1 = *(const bf16x8*)(Pw + (16 + fr) * 72 + ks * 32 + fq * 8);
#pragma unroll
            for (int nt = 0; nt < 8; ++nt) {
                const s16x4 v0 = __builtin_amdgcn_ds_read_tr16_b64_v4i16((LAS s16x4*)(vtr + (32 * ks) * 144 + 16 * nt));
                const s16x4 v1 = __builtin_amdgcn_ds_read_tr16_b64_v4i16((LAS s16x4*)(vtr + (32 * ks + 4) * 144 + 16 * nt));
                const bf16x8 bv = __builtin_shufflevector(v0, v1, 0, 1, 2, 3, 4, 5, 6, 7);
                if (val0) O[0][nt] = MFMA16(a0, bv, O[0][nt]);
                if (val1) O[1][nt] = MFMA16(a1, bv, O[1][nt]); } }
        __syncthreads();
    }
#undef NA_LOAD
    const float* ow = P.na_onorm + l * 1024 + h * 128;
#pragma unroll
    for (int q2 = 0; q2 < 2; ++q2)
#pragma unroll
        for (int j = 0; j < 4; ++j) { const float inv = rcpf_(lrow[q2][j]); float ss = 0.f;
#pragma unroll
            for (int nt = 0; nt < 8; ++nt) { const float v = O[q2][nt][j] * inv; ss += v * v; }
            ss = sum16d(ss);
            const float sc = rsqrtf(ss * (1.f / 128.f) + EPS) * inv;
            bf16_t* op = MIX + (size_t)(qrow0 + q2 * 64 + qb * 16 + fq * 4 + j) * DM + 512 + h * 128;
#pragma unroll
            for (int nt = 0; nt < 8; ++nt) op[16 * nt + fr] = (bf16_t)f2bf(O[q2][nt][j] * sc * ow[16 * nt + fr]); }
}

__device__ __forceinline__ void cv_rows8(const Params& P, int l, const bf16_t* U, bf16_t* MIX, int t0, int lane) {
    int pos, len; if (t0 < ML) { pos = t0 & (SEQ - 1); len = SEQ; } else { pos = (t0 - ML) & (CTXL - 1); len = CTXL; }
    const int ch = lane * 8;
    const bf16_t* up = U + (size_t)t0 * INW + ch;
    const bool hasp = pos > 0, hasn = pos + 8 < len;
    const u32x4 z4 = {0u, 0u, 0u, 0u};
    u32x4 rc[10], rv[10], rb[8];
#pragma unroll
    for (int r = 0; r < 10; ++r) { const bool ok = (r == 0) ? hasp : ((r == 9) ? hasn : true);
        rc[r] = ok ? *(const u32x4*)(up + (ptrdiff_t)(r - 1) * INW + C_CVC) : z4; rv[r] = ok ? *(const u32x4*)(up + (ptrdiff_t)(r - 1) * INW + C_CVV) : z4; }
#pragma unroll
    for (int r = 0; r < 8; ++r) rb[r] = *(const u32x4*)(up + (size_t)r * INW + C_CVB);
    const float* w = P.cv_w + (size_t)l * 3 * 512 + ch; const float* ow = P.cv_onorm + l * 512 + ch;
    float w0[8], w1[8], w2[8], on[8];
#pragma unroll
    for (int e = 0; e < 8; ++e) { w0[e] = w[e]; w1[e] = w[512 + e]; w2[e] = w[1024 + e]; on[e] = ow[e]; }
    float pp[8], pc[8], pn[8], a[8], b[8];
    unpack8(rc[0], a); unpack8(rv[0], b);
#pragma unroll
    for (int e = 0; e < 8; ++e) pp[e] = a[e] * b[e];
    unpack8(rc[1], a); unpack8(rv[1], b);
#pragma unroll
    for (int e = 0; e < 8; ++e) pc[e] = a[e] * b[e];
#pragma unroll
    for (int r = 0; r < 8; ++r) {
        unpack8(rc[r + 2], a); unpack8(rv[r + 2], b);
#pragma unroll
        for (int e = 0; e < 8; ++e) pn[e] = a[e] * b[e];
        float bg[8]; unpack8(rb[r], bg);
        float y[8]; float ss = 0.f;
#pragma unroll
        for (int e = 0; e < 8; ++e) { y[e] = bg[e] * (w0[e] * pp[e] + w1[e] * pc[e] + w2[e] * pn[e]); ss += y[e] * y[e]; }
        ss = sum16d(ss);
        const float rstd = rsqrtf(ss * (1.f / 128.f) + EPS);
        u32x4 o; o.x = pk2(y[0] * rstd * on[0], y[1] * rstd * on[1]); o.y = pk2(y[2] * rstd * on[2], y[3] * rstd * on[3]);
        o.z = pk2(y[4] * rstd * on[4], y[5] * rstd * on[5]); o.w = pk2(y[6] * rstd * on[6], y[7] * rstd * on[7]);
        *(u32x4*)(MIX + (size_t)(t0 + r) * DM + 1536 + ch) = o;
#pragma unroll
        for (int e = 0; e < 8; ++e) { pp[e] = pc[e]; pc[e] = pn[e]; }
    }
}

__device__ __forceinline__ void phase_fix(const float* EDGE, bf16_t* A2, const float* cw, const float* cb, int nbands, int gw, int NGW, int lane) {
    for (int it = gw; it < nbands * 2 * 8; it += NGW) {
        const int seg = it & 7, rr = it >> 3;
        const int band = rr >> 1, lastr = rr & 1, r = band * 64 + (lastr ? 63 : 0);
        int pos, len; if (r < ML) { pos = r & (SEQ - 1); len = SEQ; } else { pos = (r - ML) & (CTXL - 1); len = CTXL; }
        const bool hasp = pos > 0, hasn = pos < len - 1;
        const float* ec = EDGE + (size_t)(band * 4 + (lastr ? 3 : 0)) * FF2;
        const float* ep = ec - FF2; const float* en = ec + FF2;
        const f32x4 z4 = {0.f, 0.f, 0.f, 0.f};
#pragma unroll
        for (int k = 0; k < 3; ++k) { const int c4 = seg * 176 + k * 64 + lane;
            if (k * 64 + lane < 176) { const int col = c4 * 4;
                const f32x4 gp = hasp ? *(const f32x4*)(ep + col) : z4, gc = *(const f32x4*)(ec + col), gn = hasn ? *(const f32x4*)(en + col) : z4;
                const f32x4 vp = hasp ? *(const f32x4*)(ep + FF + col) : z4, vc = *(const f32x4*)(ec + FF + col), vn = hasn ? *(const f32x4*)(en + FF + col) : z4;
                const f32x4 cg = *(const f32x4*)(cw + col) * gp + *(const f32x4*)(cw + FF2 + col) * gc + *(const f32x4*)(cw + 2 * FF2 + col) * gn + *(const f32x4*)(cb + col);
                const f32x4 cv = *(const f32x4*)(cw + FF + col) * vp + *(const f32x4*)(cw + FF2 + FF + col) * vc + *(const f32x4*)(cw + 2 * FF2 + FF + col) * vn + *(const f32x4*)(cb + FF + col);
                u32x2 o; o.x = pk2(siluf_(cg[0]) * cv[0], siluf_(cg[1]) * cv[1]); o.y = pk2(siluf_(cg[2]) * cv[2], siluf_(cg[3]) * cv[3]);
                *(u32x2*)(A2 + (size_t)r * FF + col) = o; } }
    }
}

#define XB_TMO      128
#define XB_XCNT(j)  (256  + 64 * (j))
#define XB_XSUB(j)  (1280 + 64 * (j))
#define XB_XGEN(j)  (2304 + 64 * (j))
#define XB_TOP      3328
#define XB_TOPGEN   3392
#define XCD_BAR_WORDS 3456
#define XB_SPIN_CAP (1u << 18)

__device__ __forceinline__ unsigned xb_ld(unsigned* p)              { return __hip_atomic_load(p, __ATOMIC_RELAXED, __HIP_MEMORY_SCOPE_AGENT); }
__device__ __forceinline__ unsigned xb_add(unsigned* p, unsigned v) { return __hip_atomic_fetch_add(p, v, __ATOMIC_RELAXED, __HIP_MEMORY_SCOPE_AGENT); }
__device__ __forceinline__ unsigned xb_xcc_id() { return (unsigned)__builtin_amdgcn_s_getreg((3 << 11) | 20) & 0xFu; }
#define XB_SPIN(cond, bar) do { unsigned _sp = 0; while (cond) { __builtin_amdgcn_s_sleep(1); \
    if ((++_sp & 255u) == 0u) { if (xb_ld(&(bar)[XB_TMO])) break; if (_sp > XB_SPIN_CAP) { atomicAdd(&(bar)[XB_TMO], 1u); break; } } } } while (0)

struct XcdBarrier {
    unsigned* bar; unsigned x;
    volatile LAS unsigned* st;
};

__device__ __forceinline__ XcdBarrier xcd_barrier_post(unsigned* bar, volatile LAS unsigned* st) {
    XcdBarrier b; b.bar = bar; b.x = xb_xcc_id(); b.st = st;
    if (threadIdx.x == 0) (void)xb_add(&bar[XB_XCNT(b.x)], 1u);
    return b;
}
__device__ __forceinline__ void xcd_barrier_complete(unsigned* bar, unsigned x, unsigned& nloc, unsigned& nx) {
    const unsigned G = gridDim.x * gridDim.y * gridDim.z;
    unsigned sum, cnt, mine, sp = 0u;
    for (;;) {
        sum = 0u; cnt = 0u; mine = 0u;
#pragma unroll
        for (unsigned j = 0; j < 16; ++j) { const unsigned c = xb_ld(&bar[XB_XCNT(j)]); sum += c; cnt += (c > 0u) ? 1u : 0u; mine = (j == x) ? c : mine; }
        if (sum == G) break;
        __builtin_amdgcn_s_sleep(1);
        if ((++sp & 255u) == 0u) { if (xb_ld(&bar[XB_TMO])) break; if (sp > XB_SPIN_CAP) { atomicAdd(&bar[XB_TMO], 1u); break; } }
    }
    nloc = mine > 0u ? mine : 1u; nx = cnt > 0u ? cnt : 1u;
}

__device__ __forceinline__ void xcd_barrier(const XcdBarrier& b) {
    asm volatile("s_waitcnt vmcnt(0)" ::: "memory");
    __syncthreads();
    if (threadIdx.x == 0) {
        unsigned* bar = b.bar;
        __builtin_amdgcn_s_waitcnt(0);
        unsigned nloc = b.st[0], nx = b.st[1];
        if (nloc == 0u) { xcd_barrier_complete(bar, b.x, nloc, nx); b.st[0] = nloc; b.st[1] = nx; }
        const unsigned old = xb_add(&bar[XB_XSUB(b.x)], 1u);
        const unsigned gen = old / nloc;
        if (old + 1u == (gen + 1u) * nloc) {
            __builtin_amdgcn_fence(__ATOMIC_RELEASE, "agent");
            asm volatile("s_waitcnt vmcnt(0)" ::: "memory");
            const unsigned og = xb_add(&bar[XB_TOP], 1u);
            const unsigned tg = og / nx;
            if (og + 1u == (tg + 1u) * nx) xb_add(&bar[XB_TOPGEN], 1u);
            else XB_SPIN(xb_ld(&bar[XB_TOPGEN]) == tg, bar);
            __builtin_amdgcn_fence(__ATOMIC_ACQUIRE, "agent");
            xb_add(&bar[XB_XGEN(b.x)], 1u);
            asm volatile("s_waitcnt vmcnt(0)" ::: "memory");
        } else {
            XB_SPIN(xb_ld(&bar[XB_XGEN(b.x)]) == gen, bar);
            __builtin_amdgcn_fence(__ATOMIC_ACQUIRE, "agent");
            asm volatile("s_waitcnt vmcnt(0)" ::: "memory");
        }
    }
    __syncthreads();
}

__device__ __forceinline__ Params load_params() {
    Params r;
#if defined(__HIP_DEVICE_COMPILE__)
    typedef const __attribute__((address_space(4))) unsigned long long* U64CP;
    U64CP p = (U64CP)__builtin_amdgcn_kernarg_segment_ptr();
    asm volatile("" : "+s"(p));
    const float** d = (const float**)&r;
#pragma unroll
    for (int i = 0; i < (int)(sizeof(Params) / 8); ++i) d[i] = (const float*)(const GAS float*)(p[i]);
#endif
    return r;
}
#define PHASE_BEGIN const Params P = load_params(); const int lane = (int)__builtin_amdgcn_mbcnt_hi(~0u, __builtin_amdgcn_mbcnt_lo(~0u, (unsigned)opaque_s(0))), wave = opaque_s(wave_s), tid = wave * 64 + lane; \
    const int bid = opaque_s(blockIdx.x), G = opaque_s(gridDim.x), gw = bid * 8 + wave, NGW = G * 8; unsigned char* ws = P.ws; \
    (void)lane; (void)gw; (void)NGW; (void)ws;
#ifndef REP_MASK
#define REP_MASK 0
#endif
#define REP(bit) for (int rep_ = 0; rep_ < (((REP_MASK) >> (bit)) & 1) + 1; ++rep_)
#ifndef SYNC_REP
#define SYNC_REP 1
#endif
#define GSYNC do { for (int sr_ = 0; sr_ < SYNC_REP; ++sr_) { const Params Pb_ = load_params(); XcdBarrier xb_; xb_.bar = (unsigned*)(Pb_.ws + WS_BAR); xb_.x = xb_xcc_id(); xb_.st = (volatile LAS unsigned*)(ldsl + (LDS_BYTES - 16)); xcd_barrier(xb_); } } while (0)
#define DYN_LOOP_BEGIN(CTRIDX, NITEMS) { unsigned* ctr_ = (unsigned*)(ws + WS_CTR) + (CTRIDX) * 64; volatile LAS unsigned* slot_ = (volatile LAS unsigned*)(ldsl + (LDS_BYTES - 32)); \
    int it = bid; while (it < (NITEMS)) { unsigned nx_ = 0u; if (tid_ == 0) nx_ = __hip_atomic_fetch_add(ctr_, 1u, __ATOMIC_RELAXED, __HIP_MEMORY_SCOPE_AGENT) + (unsigned)G;
#define DYN_LOOP_END __syncthreads(); if (tid_ == 0) slot_[0] = nx_; __syncthreads(); it = (int)slot_[0]; __syncthreads(); } }
#define ADA_L ((const float*)(ws + WS_ADA) + (size_t)l * 5 * ADA_W)
#define WT_L (ws + WS_WT + (size_t)l * WT_LAYER)

__global__ void __launch_bounds__(512, 2) mega(Params Pk) {
    extern __shared__ __attribute__((aligned(16))) unsigned char lds[];
    cg::grid_group grid = cg::this_grid();
    LAS unsigned char* ldsl = (LAS unsigned char*)lds;
    const int wave_s = __builtin_amdgcn_readfirstlane((int)threadIdx.x >> 6);
    { PHASE_BEGIN
      if (bid == 0) { for (int i = tid; i < XCD_BAR_WORDS; i += 512) ((unsigned*)(ws + WS_BAR))[i] = 0u;
                      if (tid < 8) ((unsigned*)(ws + WS_CTR))[tid * 64] = 0u; }
      if (tid < 4) ((volatile LAS unsigned*)(ldsl + (LDS_BYTES - 16)))[tid] = 0u; }
    REP(0) { { PHASE_BEGIN phase0(P, lds, tid, lane, wave, bid, G); }
    grid.sync(); }
    { PHASE_BEGIN (void)xcd_barrier_post((unsigned*)(ws + WS_BAR), (volatile LAS unsigned*)(ldsl + (LDS_BYTES - 16))); }
#pragma unroll 1
    for (int l = 0; l < 2; ++l) {
        const bool lastl = (l == 1);
        REP(1) { { PHASE_BEGIN
          const float* xin_l = lastl ? (const float*)(ws + WS_X2B) : P.x; const float* xin_c = lastl ? (const float*)(ws + WS_X1) + (size_t)ML * DM : P.ctx;
          phase_norm(lastl, xin_l, xin_c, lastl ? (const float*)(ws + WS_PART) : nullptr, P.ln1_w + l * DM, ADA_L, 0, MA, (bf16_t*)(ws + WS_HA), nullptr, gw, NGW, lane); }
        GSYNC; }
        REP(2) { { PHASE_BEGIN
          pg8::Gemm g{(const bf16_t*)(ws + WS_HA), (const bf16_t*)WT_L, DM}; pg8::SegOrder S; S.init(64, 28, 4, lastl ? 14 : 28, G, bid, 32); pg8::EpiU E{(bf16_t*)(ws + WS_U), INW}; pg8::gemm_phase(ldsl, g, S, E, tid); }
        GSYNC; }
        REP(3) { { PHASE_BEGIN
          const int tid_ = tid;
          const bf16_t* U = (const bf16_t*)(ws + WS_U); bf16_t* MIX = (bf16_t*)(ws + WS_MIX);
          const int nNAc = lastl ? 0 : 32, nNA = 512 + nNAc, nHG = 0, nCV = lastl ? 256 : 272;
          hg_local_static(P, l, U, 32 * NCHUNK, bid, G, lds, opaque_v(tid_));
          DYN_LOOP_BEGIN(l * 2 + 0, nNA + nHG + nCV)
              const int tid = opaque_v(tid_), lane = tid & 63;
              if (it < 512) { const int hp = it & 3, rp = (it >> 2) & 31, b = it >> 7; REP(9) na_item(P, l, U, MIX, b * SEQ + rp * 128, b, 2 * rp, hp, true, lds, tid); }
              else if (it < nNA) { const int i2 = it - 512, hp = i2 & 3, qk = (i2 >> 2) & 1, b = i2 >> 3; na_item(P, l, U, MIX, ML + b * CTXL + qk * 128, b, 0, hp, false, lds, tid); }
              else if (it < nNA + nHG) { REP(10) hg_local_item(P, l, U, it - nNA, lds, tid); }
              else { const int t0 = (it - nNA - nHG) * 64;
                  cv_rows8(P, l, U, MIX, t0 + wave * 8, lane); }
          DYN_LOOP_END }
        GSYNC; }
        REP(4) { { PHASE_BEGIN hg_scan(P, tid, bid, G); }
        GSYNC; }
        REP(5) { { PHASE_BEGIN
          const int tid_ = tid;
          const bf16_t* U = (const bf16_t*)(ws + WS_U); bf16_t* MIX = (bf16_t*)(ws + WS_MIX);
          const int nit = lastl ? 1024 : 1088;
          DYN_LOOP_BEGIN(l * 2 + 1, nit)
              const int tid = opaque_v(tid_);
              int b, h, pc; if (lastl) { pc = 4 + (it & 63); h = (it >> 6) & 3; b = it >> 8; } else { pc = it % NCHUNK; h = (it / NCHUNK) & 3; b = it / (NCHUNK * 4); }
              hg_out_item(P, l, U, MIX, b, h, pc, lds, tid);
          DYN_LOOP_END
          }
        GSYNC; }
        REP(6) { { PHASE_BEGIN
          const float* xin_l = lastl ? (const float*)(ws + WS_X2B) : P.x; const float* xin_c = P.ctx; float* X1 = (float*)(ws + WS_X1);
          pg8::Gemm g{(const bf16_t*)(ws + WS_MIX), (const bf16_t*)(WT_L + WT_OUT_OFF), DM}; pg8::SegOrder S; S.init(64, 8, 4, lastl ? 0 : 8, G, bid, 32, 4);
          pg8::EpiRes E{xin_l, xin_c, X1, (float*)(ws + WS_PART), ADA_L, 2, 32, true, lastl}; pg8::gemm_phase(ldsl, g, S, E, tid); }
        GSYNC; }
        REP(1) { { PHASE_BEGIN
          float* X1 = (float*)(ws + WS_X1);
          phase_norm(true, X1, P.ctx, lastl ? nullptr : (const float*)(ws + WS_PART), P.ln2_w + l * DM, ADA_L, 3, lastl ? ML : MA, (bf16_t*)(ws + WS_HA), lastl ? nullptr : X1 + (size_t)ML * DM, gw, NGW, lane); }
        GSYNC; }
        REP(7) { { PHASE_BEGIN
          pg8::Gemm g{(const bf16_t*)(ws + WS_HA), (const bf16_t*)(WT_L + WT_UP_OFF), DM}; pg8::SegOrder S; S.init(64, 44, 4, lastl ? 0 : 44, G, bid, 32);
          pg8::EpiUp E{(bf16_t*)(ws + WS_U), (float*)(ws + WS_EDGE), P.f_cw + (size_t)l * 3 * FF2, P.f_cb + (size_t)l * FF2}; pg8::gemm_phase(ldsl, g, S, E, tid); }
        GSYNC; }
        REP(1) { { PHASE_BEGIN
          phase_fix((const float*)(ws + WS_EDGE), (bf16_t*)(ws + WS_U), P.f_cw + (size_t)l * 3 * FF2, P.f_cb + (size_t)l * FF2, lastl ? 256 : 272, gw, NGW, lane); }
        GSYNC; }
        REP(8) { { PHASE_BEGIN
          float* X1 = (float*)(ws + WS_X1);
          pg8::Gemm g{(const bf16_t*)(ws + WS_U), (const bf16_t*)(WT_L + WT_DN_OFF), FF}; pg8::SegOrder S; S.init(64, 8, 4, lastl ? 0 : 8, G, bid, 88, 4);
          pg8::EpiRes E{X1, X1 + (size_t)ML * DM, lastl ? P.out : (float*)(ws + WS_X2B), (float*)(ws + WS_PART), ADA_L, 5, 88, !lastl, true}; pg8::gemm_phase(ldsl, g, S, E, tid); }
        if (!lastl) GSYNC; }
    }
}

extern "C" void kernel_launch(void* const* d_in, const int* in_sizes, int n_in, void* d_out, int out_size, void* d_ws, size_t ws_size, hipStream_t stream) {
    static int grid = 0;
    if (grid == 0) {
        if (n_in != 22 || out_size != ML * DM || ws_size < WS_END) { fprintf(stderr, "kernel_launch: unexpected shapes (n_in %d, out %d, ws %zu); nothing launched\n", n_in, out_size, ws_size); grid = -1; return; }
        int dev = 0, cus = 0, per_cu = 0;
        if (hipGetDevice(&dev) != hipSuccess || hipDeviceGetAttribute(&cus, hipDeviceAttributeMultiprocessorCount, dev) != hipSuccess) { grid = -1; return; }
        if (hipFuncSetAttribute((const void*)mega, hipFuncAttributeMaxDynamicSharedMemorySize, LDS_BYTES) != hipSuccess) { fprintf(stderr, "kernel_launch: hipFuncSetAttribute failed\n"); grid = -1; return; }
        if (hipOccupancyMaxActiveBlocksPerMultiprocessor(&per_cu, (const void*)mega, 512, LDS_BYTES) != hipSuccess || per_cu < 1) per_cu = 1;
        (void)hipGetLastError();
        grid = cus;
    }
    if (grid < 0) return;
    Params p{};
    const float** pp = (const float**)&p;
    for (int i = 0; i < 22; ++i) pp[i] = (const float*)d_in[i];
    p.out = (float*)d_out; p.ws = (unsigned char*)d_ws;
    void* args[] = {&p};
    hipError_t e = hipLaunchCooperativeKernel((const void*)mega, dim3(grid), dim3(512), args, LDS_BYTES, stream);
    if (e != hipSuccess) fprintf(stderr, "cooperative launch failed: %s (grid %d)\n", hipGetErrorString(e), grid);
}
```

```cpp
#include <hip/hip_runtime.h>
#include <hip/hip_cooperative_groups.h>
#include <cstdio>
#include <cstdint>
namespace cg = cooperative_groups;

#define LAS __attribute__((address_space(3)))
#define GAS __attribute__((address_space(1)))
typedef unsigned short bf16_t;
typedef short bf16x8 __attribute__((ext_vector_type(8)));
typedef float f32x4 __attribute__((ext_vector_type(4)));
typedef unsigned u32x4 __attribute__((ext_vector_type(4)));
typedef unsigned u32x2 __attribute__((ext_vector_type(2)));

constexpr int DM = 2048, NB = 4, SEQ = 4096, CTXL = 256;
constexpr int ML = NB * SEQ;
constexpr int MC = NB * CTXL;
constexpr int MA = ML + MC;
constexpr int INW = 7168, FF = 5632, FF2 = 11264;
constexpr int ADA_W = 12288;
constexpr float EPS = 1e-6f;
constexpr float ATTN_SCALE = 0.08838834764831845f;
constexpr int NCHUNK = 68;
constexpr int C_FFW = 0, C_FBW = 512, C_IV = 1024, C_NAK = 1536, C_NAV = 2560, C_HGQ = 3584, C_HGG = 4096, C_NAQ = 4608, C_CVB = 5632, C_CVC = 6144, C_CVV = 6656;

constexpr size_t MiB = 1u << 20;
constexpr size_t WS_ADA = 0;
constexpr size_t WS_BAR = 512 * 1024;
constexpr size_t WS_CTR = 768 * 1024;
constexpr size_t WS_DC = 1 * MiB;
constexpr size_t WS_WT = 3 * MiB;
constexpr size_t WT_LAYER = 102 * MiB, WT_OUT_OFF = 28 * MiB, WT_UP_OFF = 36 * MiB, WT_DN_OFF = 80 * MiB;
constexpr size_t WS_X2B = 3 * MiB;
constexpr size_t WS_HA = 207 * MiB;
constexpr size_t WS_X1 = 275 * MiB;
constexpr size_t WS_CTX2 = 411 * MiB;
constexpr size_t WS_U = 419 * MiB;
constexpr size_t WS_EDGE = WS_U + 187 * MiB;
constexpr size_t WS_MIX = 657 * MiB;
constexpr size_t WS_PART = 725 * MiB;
constexpr size_t WS_END = 757 * MiB;
constexpr int LDS_BYTES = 147456;

struct Params {
    const float *x, *c, *ctx, *c_ctx, *w_ada, *b_ada, *ln1_w, *ln2_w, *w_in, *hg_lb, *hg_norm_w, *q_norm_w, *k_norm_w, *rpb, *na_onorm, *cv_w, *cv_onorm, *w_out, *w_up, *f_cw, *f_cb, *w_down;
    float* out; unsigned char* ws;
};

__device__ __forceinline__ float bf2f(bf16_t v) { return __uint_as_float(((unsigned)v) << 16); }
__device__ __forceinline__ unsigned pk2(float lo, float hi) { unsigned r; asm("v_cvt_pk_bf16_f32 %0, %1, %2" : "=v"(r) : "v"(lo), "v"(hi)); return r; }
__device__ __forceinline__ unsigned f2bf(float f) { return pk2(f, f) & 0xffffu; }
__device__ __forceinline__ float lo16(unsigned w) { return __uint_as_float(w << 16); }
__device__ __forceinline__ float hi16(unsigned w) { return __uint_as_float(w & 0xffff0000u); }
__device__ __forceinline__ float rsqf_(float x) { return __builtin_amdgcn_rsqf(x); }
__device__ __forceinline__ float rcpf_(float x) { return __builtin_amdgcn_rcpf(x); }
__device__ __forceinline__ float siluf_(float x) { return x * rcpf_(1.f + __expf(-x)); }
__device__ __forceinline__ float xshfl(float v, int mask, int lane) { return __builtin_bit_cast(float, __builtin_amdgcn_ds_bpermute((lane ^ mask) << 2, __builtin_bit_cast(int, v))); }
__device__ __forceinline__ float wave_sum(float v, int lane) {
#pragma unroll
    for (int o = 1; o < 64; o <<= 1) v += xshfl(v, o, lane);
    return v;
}
__device__ __forceinline__ float sum16(float v, int lane) { v += xshfl(v, 1, lane); v += xshfl(v, 2, lane); v += xshfl(v, 4, lane); v += xshfl(v, 8, lane); return v; }
__device__ __forceinline__ float max16(float v, int lane) { v = fmaxf(v, xshfl(v, 1, lane)); v = fmaxf(v, xshfl(v, 2, lane)); v = fmaxf(v, xshfl(v, 4, lane)); v = fmaxf(v, xshfl(v, 8, lane)); return v; }
__device__ __forceinline__ const float* rowp(const float* lat, const float* cx, int r) { return r < ML ? lat + (size_t)r * DM : cx + (size_t)(r - ML) * DM; }
__device__ __forceinline__ void unpack8(u32x4 w, float (&f)[8]) {
    f[0] = lo16(w.x); f[1] = hi16(w.x); f[2] = lo16(w.y); f[3] = hi16(w.y); f[4] = lo16(w.z); f[5] = hi16(w.z); f[6] = lo16(w.w); f[7] = hi16(w.w);
}
__device__ __forceinline__ bf16x8 as_frag(u32x4 w) { union { u32x4 u; bf16x8 b; } c; c.u = w; return c.b; }
__device__ __forceinline__ float dpp_ror1(float v) { const int iv = __builtin_bit_cast(int, v); return __builtin_bit_cast(float, __builtin_amdgcn_update_dpp(iv, iv, 0x121, 0xf, 0xf, false)); }
__device__ __forceinline__ float dpp_ror15(float v) { const int iv = __builtin_bit_cast(int, v); return __builtin_bit_cast(float, __builtin_amdgcn_update_dpp(iv, iv, 0x12F, 0xf, 0xf, false)); }
template <int CTRL> __device__ __forceinline__ float dppf(float v) { const int iv = __builtin_bit_cast(int, v); return __builtin_bit_cast(float, __builtin_amdgcn_update_dpp(iv, iv, CTRL, 0xf, 0xf, false)); }
__device__ __forceinline__ float sum16d(float v) { v += dppf<0xB1>(v); v += dppf<0x4E>(v); v += dppf<0x141>(v); v += dppf<0x128>(v); return v; }
__device__ __forceinline__ float max16d(float v) { v = fmaxf(v, dppf<0xB1>(v)); v = fmaxf(v, dppf<0x4E>(v)); v = fmaxf(v, dppf<0x141>(v)); v = fmaxf(v, dppf<0x128>(v)); return v; }
typedef short s16x4 __attribute__((ext_vector_type(4)));
__device__ __forceinline__ int opaque_v(int x) { asm volatile("" : "+v"(x)); return x; }
__device__ __forceinline__ int opaque_s(int x) { asm volatile("" : "+s"(x)); return x; }
#define MFMA16(a, b, c) __builtin_amdgcn_mfma_f32_16x16x32_bf16((a), (b), (c), 0, 0, 0)

namespace pg8 {
constexpr int BM = 256, BK = 64, HALF = 128, HTB = HALF * BK * 2, STAGE_BYTES = 8 * HTB, NXCD = 8, WGM = 8;
__device__ __forceinline__ int lds_byte(int r, int c) { const int st = (r >> 4) * 2 + (c >> 5), rr = r & 15, cc = c & 31, ob = rr * 64 + cc * 2; return st * 1024 + (ob ^ (((ob >> 9) & 1) << 5)); }
__device__ __forceinline__ void stage_rc(int b, int& R, int& C) { const int st = b / 1024, sb = b % 1024, swz = sb ^ (((sb >> 9) & 1) << 5); R = (st >> 1) * 16 + swz / 64; C = (st & 1) * 32 + (swz % 64) / 2; }
__device__ __forceinline__ int perm32(int rho) { const int n = rho >> 4, i = rho & 15; return 8 * (i >> 2) + 4 * n + (i & 3); }
struct Unit { int pm, pn, kt0, nt; };
struct Gemm { const bf16_t* A; const bf16_t* Bt; int K; };
struct SegOrder {
    int nM, nN, n0, nM1, n1, G, c, ntf, ksp;
    __device__ void init(int nM0_, int nN0_, int nM1_, int nN1_, int G_, int c_, int ntf_, int ksp_ = 1) { nM = nM0_; nN = nN0_; n0 = nM * nN; nM1 = nM1_; n1 = nM1_ * nN1_ * ksp_; G = G_; c = c_; ntf = ntf_; ksp = ksp_; }
    __device__ bool next(int i, Unit& u) const {
        const long L = (long)i * G + c; if (L >= n0 + n1) return false;
        u.kt0 = 0; u.nt = ntf;
        if (L >= n0) { int r = (int)L - n0; const int ks = r % ksp; r /= ksp; u.pm = 64 + (r % nM1); u.pn = r / nM1; u.nt = ntf / ksp; u.kt0 = ks * u.nt; return true; }
        int wgid = (int)L; { const int q = n0 / NXCD, r = n0 % NXCD, xcd = wgid % NXCD, off = wgid / NXCD; wgid = (xcd < r ? xcd * (q + 1) : r * (q + 1) + (xcd - r) * q) + off; }
        const int nig = WGM * nN, gid = wgid / nig, fm = gid * WGM, gsz = (nM - fm) < WGM ? (nM - fm) : WGM;
        u.pm = fm + ((wgid % nig) % gsz); u.pn = (wgid % nig) / gsz; return true;
    }
};
__device__ __forceinline__ unsigned cvt_pk_bf16(float lo, float hi) { unsigned r; asm volatile("v_cvt_pk_bf16_f32 %0, %1, %2" : "=v"(r) : "v"(lo), "v"(hi)); return r; }

template <class Epi>
__device__ __forceinline__ void gemm_phase(LAS unsigned char* lds, const Gemm g, const SegOrder& S, const Epi& E, const int tid) {
    const int wid = __builtin_amdgcn_readfirstlane(tid >> 6), lane = tid & 63, wr = wid >> 2, wc = wid & 3, fr = lane & 15, fq = lane >> 4;
    const int K = g.K;
    unsigned voffA[2], voffB[2];
#pragma unroll
    for (int i = 0; i < 2; ++i) { int R, C; stage_rc(tid * 16 + i * 8192, R, C); const int Rb = Epi::PERM ? ((R & ~31) + perm32(R & 31)) : R;
        voffA[i] = (unsigned)(R * K + C) * 2u; voffB[i] = (unsigned)(Rb * K + C) * 2u; }
    const size_t kstep = (size_t)(BK * 2);
    const size_t hstep = (size_t)HALF * K * 2;
    const size_t tstep = 2 * hstep;
    const unsigned ldsw = (unsigned)wid * 1024u;
    const int aoff = lds_byte(wr * 64 + fr, fq * 8), boff = lds_byte(wc * 32 + fr, fq * 8);
#define PG8_SA(b, h) (((b) * 2 + (h)) * HTB)
#define PG8_SB(b, h) ((4 + (b) * 2 + (h)) * HTB)
#define PG8_STAGE(bufoff, gbase, voff) do { _Pragma("unroll") for (int _i = 0; _i < 2; ++_i) \
        __builtin_amdgcn_global_load_lds((const unsigned*)((const char*)(gbase) + (voff)[_i]), (LAS unsigned*)(lds + (bufoff) + ldsw + _i * 8192), 16, 0, 0); } while (0)
#define PG8_LDA(dst, b, h) do { _Pragma("unroll") for (int m = 0; m < 4; ++m) _Pragma("unroll") for (int k = 0; k < 2; ++k) dst[m][k] = *(const LAS bf16x8*)(lds + PG8_SA(b, h) + aoff + m * 2048 + k * 1024); } while (0)
#define PG8_LDB(dst, b, h) do { _Pragma("unroll") for (int n = 0; n < 2; ++n) _Pragma("unroll") for (int k = 0; k < 2; ++k) dst[n][k] = *(const LAS bf16x8*)(lds + PG8_SB(b, h) + boff + n * 2048 + k * 1024); } while (0)
#define PG8_MMA(ai, bj, At, Bt) do { __builtin_amdgcn_s_setprio(1); _Pragma("unroll") for (int m = 0; m < 4; ++m) _Pragma("unroll") for (int n = 0; n < 2; ++n) _Pragma("unroll") for (int k = 0; k < 2; ++k) \
        acc[ai][bj][m][n] = __builtin_amdgcn_mfma_f32_16x16x32_bf16(Bt[n][k], At[m][k], acc[ai][bj][m][n], 0, 0, 0); __builtin_amdgcn_s_setprio(0); } while (0)
#define PG8_WAIT_V(n) asm volatile("s_waitcnt vmcnt(" #n ")" ::: "memory")
#define PG8_WAIT_L(n) asm volatile("s_waitcnt lgkmcnt(" #n ")" ::: "memory")
#define PG8_BAR __builtin_amdgcn_s_barrier()
#define PG8_SCHED __builtin_amdgcn_sched_barrier(0)
    Unit cur, nxt; int ui = 0;
    if (!S.next(0, cur)) return;
    f32x4 acc[2][2][4][2];
#pragma unroll
    for (int a = 0; a < 2; ++a)
#pragma unroll
        for (int b = 0; b < 2; ++b)
#pragma unroll
            for (int m = 0; m < 4; ++m)
#pragma unroll
                for (int n = 0; n < 2; ++n) acc[a][b][m][n] = (f32x4){0.f, 0.f, 0.f, 0.f};
    bf16x8 At[4][2], B0[2][2], B1[2][2];
    const char* cA = (const char*)g.A + (size_t)cur.pm * tstep + (size_t)cur.kt0 * kstep; const char* cB = (const char*)g.Bt + (size_t)cur.pn * tstep + (size_t)cur.kt0 * kstep;
    PG8_STAGE(PG8_SB(0, 0), cB, voffB); PG8_STAGE(PG8_SB(0, 1), cB + hstep, voffB); PG8_STAGE(PG8_SA(0, 0), cA, voffA); PG8_STAGE(PG8_SA(0, 1), cA + hstep, voffA);
    if (wr == 1) PG8_BAR;
    PG8_WAIT_V(2); PG8_BAR;
    PG8_STAGE(PG8_SB(1, 0), cB + kstep, voffB); PG8_STAGE(PG8_SA(1, 0), cA + kstep, voffA); PG8_STAGE(PG8_SB(1, 1), cB + hstep + kstep, voffB);
    PG8_WAIT_V(6); PG8_BAR;
    for (;;) {
        const bool has_next = S.next(ui + 1, nxt);
        const char* nA = has_next ? (const char*)g.A + (size_t)nxt.pm * tstep + (size_t)nxt.kt0 * kstep : cA; const char* nB = has_next ? (const char*)g.Bt + (size_t)nxt.pn * tstep + (size_t)nxt.kt0 * kstep : cB;
        const int nt = cur.nt;
        for (int t = 0; t < nt; t += 2) {
            const bool last = (t == nt - 2);
            const char* a1 = cA + (size_t)(t + 1) * kstep;
            const char* a2 = last ? nA : cA + (size_t)(t + 2) * kstep; const char* b2 = last ? nB : cB + (size_t)(t + 2) * kstep;
            const char* a3 = a2 + kstep; const char* b3 = b2 + kstep;
            PG8_LDB(B0, 0, 0); PG8_LDB(B1, 0, 1); PG8_SCHED; PG8_LDA(At, 0, 0); PG8_STAGE(PG8_SA(1, 1), a1 + hstep, voffA);
            PG8_WAIT_V(8); PG8_WAIT_L(0); PG8_BAR; PG8_MMA(0, 0, At, B0); PG8_MMA(0, 1, At, B1); PG8_BAR; PG8_SCHED;
            PG8_LDA(At, 0, 1); PG8_STAGE(PG8_SB(0, 0), b2, voffB); PG8_STAGE(PG8_SB(0, 1), b2 + hstep, voffB); PG8_STAGE(PG8_SA(0, 0), a2, voffA);
            PG8_WAIT_V(8); PG8_WAIT_L(0); PG8_BAR; PG8_MMA(1, 0, At, B0); PG8_MMA(1, 1, At, B1); PG8_BAR; PG8_SCHED;
            PG8_LDB(B0, 1, 0); PG8_LDB(B1, 1, 1); PG8_SCHED; PG8_LDA(At, 1, 0); PG8_STAGE(PG8_SA(0, 1), a2 + hstep, voffA);
            PG8_WAIT_V(8); PG8_WAIT_L(0); PG8_BAR; PG8_MMA(0, 0, At, B0); PG8_MMA(0, 1, At, B1); PG8_BAR; PG8_SCHED;
            PG8_LDA(At, 1, 1); PG8_STAGE(PG8_SB(1, 0), b3, voffB); PG8_STAGE(PG8_SB(1, 1), b3 + hstep, voffB); PG8_STAGE(PG8_SA(1, 0), a3, voffA);
            PG8_WAIT_V(8); PG8_WAIT_L(0); PG8_BAR; PG8_MMA(1, 0, At, B0); PG8_MMA(1, 1, At, B1); PG8_BAR; PG8_SCHED;
        }
        if (wr == 0) PG8_BAR;
        E(acc, cur, wr, wc, fr, fq);
        if (!has_next) break;
#pragma unroll
        for (int a = 0; a < 2; ++a)
#pragma unroll
            for (int b = 0; b < 2; ++b)
#pragma unroll
                for (int m = 0; m < 4; ++m)
#pragma unroll
                    for (int n = 0; n < 2; ++n) acc[a][b][m][n] = (f32x4){0.f, 0.f, 0.f, 0.f};
        cur = nxt; cA = nA; cB = nB; ++ui;
        if (wr == 1) PG8_BAR;
    }
    PG8_WAIT_V(0);
    PG8_BAR;
#undef PG8_SA
#undef PG8_SB
#undef PG8_STAGE
#undef PG8_LDA
#undef PG8_LDB
#undef PG8_MMA
#undef PG8_WAIT_V
#undef PG8_WAIT_L
#undef PG8_BAR
#undef PG8_SCHED
}

struct EpiU {
    static constexpr bool PERM = true;
    bf16_t* O; int ldc;
    __device__ __forceinline__ void operator()(const f32x4 (&acc)[2][2][4][2], const Unit& u, int wr, int wc, int fr, int fq) const {
        const int row0 = u.pm * BM + wr * 64 + fr, col0 = u.pn * BM + wc * 32 + 8 * fq;
#pragma unroll
        for (int ai = 0; ai < 2; ++ai)
#pragma unroll
            for (int m = 0; m < 4; ++m) { bf16_t* rp = O + (size_t)(row0 + ai * HALF + m * 16) * ldc + col0;
#pragma unroll
                for (int bj = 0; bj < 2; ++bj) { const f32x4 v0 = acc[ai][bj][m][0], v1 = acc[ai][bj][m][1];
                    u32x4 w; w.x = cvt_pk_bf16(v0[0], v0[1]); w.y = cvt_pk_bf16(v0[2], v0[3]); w.z = cvt_pk_bf16(v1[0], v1[1]); w.w = cvt_pk_bf16(v1[2], v1[3]);
                    *(u32x4*)(rp + bj * HALF) = w; } }
    }
};
struct EpiRes {
    static constexpr bool PERM = false;
    const float* base_l; const float* base_c; float* out_l; float* out_c; const float* ada_l; int gi; int ntf; bool OUTB, BASEB;
    __device__ __forceinline__ void operator()(const f32x4 (&acc)[2][2][4][2], const Unit& u, int wr, int wc, int fr, int fq) const {
        const bool isc = u.pm >= 64;
        const int rb = isc ? (u.pm - 64) * BM : u.pm * BM;
        const float* base = isc ? base_c : base_l; float* out = isc ? out_c : out_l;
        const int bsel = isc ? 4 : (u.pm >> 4);
        const int row0 = rb + wr * 64 + fr, col0 = u.pn * BM + wc * 32 + 4 * fq;
        const float* gate = ada_l + (size_t)bsel * ADA_W + gi * DM + col0;
        f32x4 gv[2][2];
#pragma unroll
        for (int bj = 0; bj < 2; ++bj)
#pragma unroll
            for (int n = 0; n < 2; ++n) gv[bj][n] = *(const f32x4*)(gate + bj * HALF + n * 16);
        const bool split = (u.nt != ntf);
        if (split) {
            float* po = out + (size_t)(u.kt0 / u.nt) * ((size_t)MC * DM);
#pragma unroll
            for (int ai = 0; ai < 2; ++ai)
#pragma unroll
                for (int m = 0; m < 4; ++m) { const size_t off = (size_t)(row0 + ai * HALF + m * 16) * DM + col0;
#pragma unroll
                    for (int bj = 0; bj < 2; ++bj)
#pragma unroll
                        for (int n = 0; n < 2; ++n) *(f32x4*)(po + off + bj * HALF + n * 16) = gv[bj][n] * acc[ai][bj][m][n]; }
        } else {
            f32x4 bcur[4], bnxt[4];
            const bf16_t* baseb = (const bf16_t*)base; bf16_t* outb = (bf16_t*)out;
#define EPIRES_LD(dst, o_) do { if (BASEB) { const u32x2 w_ = *(const u32x2*)(baseb + (o_)); dst = (f32x4){lo16(w_.x), hi16(w_.x), lo16(w_.y), hi16(w_.y)}; } else dst = *(const f32x4*)(base + (o_)); } while (0)
#pragma unroll
            for (int bj = 0; bj < 2; ++bj)
#pragma unroll
                for (int n = 0; n < 2; ++n) EPIRES_LD(bcur[bj * 2 + n], (size_t)row0 * DM + col0 + bj * HALF + n * 16);
#pragma unroll
            for (int g8 = 0; g8 < 8; ++g8) { const int ai = g8 >> 2, m = g8 & 3;
                const size_t off = (size_t)(row0 + ai * HALF + m * 16) * DM + col0;
                if (g8 < 7) { const int ai2 = (g8 + 1) >> 2, m2 = (g8 + 1) & 3; const size_t off2 = (size_t)(row0 + ai2 * HALF + m2 * 16) * DM + col0;
#pragma unroll
                    for (int bj = 0; bj < 2; ++bj)
#pragma unroll
                        for (int n = 0; n < 2; ++n) EPIRES_LD(bnxt[bj * 2 + n], off2 + bj * HALF + n * 16); }
#pragma unroll
                for (int bj = 0; bj < 2; ++bj)
#pragma unroll
                    for (int n = 0; n < 2; ++n) { const f32x4 r_ = bcur[bj * 2 + n] + gv[bj][n] * acc[ai][bj][m][n];
                        if (OUTB) { u32x2 w_; w_.x = cvt_pk_bf16(r_[0], r_[1]); w_.y = cvt_pk_bf16(r_[2], r_[3]); *(u32x2*)(outb + off + bj * HALF + n * 16) = w_; }
                        else *(f32x4*)(out + off + bj * HALF + n * 16) = r_; }
#pragma unroll
                for (int k = 0; k < 4; ++k) bcur[k] = bnxt[k];
                __builtin_amdgcn_sched_barrier(0);
            }
#undef EPIRES_LD
        }
    }
};
struct EpiUp {
    static constexpr bool PERM = true;
    bf16_t* A2; float* EDGE; const float* cw; const float* cb;
    __device__ __forceinline__ void operator()(const f32x4 (&acc)[2][2][4][2], const Unit& u, int wr, int wc, int fr_, int fq_) const {
        const int lane_ = (int)__builtin_amdgcn_mbcnt_hi(~0u, __builtin_amdgcn_mbcnt_lo(~0u, (unsigned)opaque_s(0))); const int fr = lane_ & 15, fq = lane_ >> 4; (void)fr_; (void)fq_;
        const int ucol = u.pn * HALF + wc * 32;
        const GAS char* wb = (const GAS char*)(cw + ucol); const GAS char* bb = (const GAS char*)(cb + ucol);
        GAS char* a2g = (GAS char*)A2; GAS char* edg = (GAS char*)EDGE;
        const GAS char* pg0 = wb; const GAS char* pg1 = wb + FF2 * 4; const GAS char* pg2 = wb + 2 * FF2 * 4; const GAS char* pv0 = wb + FF * 4; const GAS char* pv1 = wb + (FF2 + FF) * 4; const GAS char* pv2 = wb + (2 * FF2 + FF) * 4;
        const GAS char* pbg = bb; const GAS char* pbv = bb + FF * 4;
        asm volatile("" : "+s"(pg0), "+s"(pg1), "+s"(pg2), "+s"(pv0), "+s"(pv1), "+s"(pv2), "+s"(pbg), "+s"(pbv));
        const unsigned lo = (unsigned)(32 * fq);
        const int rowb = u.pm * BM + wr * 64;
#pragma unroll
        for (int n = 0; n < 2; ++n) {
            const f32x4 wg0 = *(const GAS f32x4*)(pg0 + lo + n * 16), wg1 = *(const GAS f32x4*)(pg1 + lo + n * 16), wg2 = *(const GAS f32x4*)(pg2 + lo + n * 16), bg = *(const GAS f32x4*)(pbg + lo + n * 16);
            const f32x4 wv0 = *(const GAS f32x4*)(pv0 + lo + n * 16), wv1 = *(const GAS f32x4*)(pv1 + lo + n * 16), wv2 = *(const GAS f32x4*)(pv2 + lo + n * 16), bv = *(const GAS f32x4*)(pbv + lo + n * 16);
#pragma unroll
            for (int ai = 0; ai < 2; ++ai) {
                const unsigned rowoff = (unsigned)((rowb + ai * HALF + fr) * FF + ucol) * 2u + lo / 2u;
                float res[4][4];
#pragma unroll
                for (int j = 0; j < 4; ++j) {
                    float Gv[4], Vv[4], GR[4], GL[4], VR[4], VL[4];
#pragma unroll
                    for (int m = 0; m < 4; ++m) { Gv[m] = acc[ai][0][m][n][j]; Vv[m] = acc[ai][1][m][n][j];
                        GR[m] = dpp_ror1(Gv[m]); GL[m] = dpp_ror15(Gv[m]); VR[m] = dpp_ror1(Vv[m]); VL[m] = dpp_ror15(Vv[m]); }
#pragma unroll
                    for (int m = 0; m < 4; ++m) {
                        const float gp = (fr == 0) ? (m > 0 ? GR[m > 0 ? m - 1 : 0] : 0.f) : GR[m];
                        const float gn = (fr == 15) ? (m < 3 ? GL[m < 3 ? m + 1 : 3] : 0.f) : GL[m];
                        const float vp = (fr == 0) ? (m > 0 ? VR[m > 0 ? m - 1 : 0] : 0.f) : VR[m];
                        const float vn = (fr == 15) ? (m < 3 ? VL[m < 3 ? m + 1 : 3] : 0.f) : VL[m];
                        const float cgv = wg0[j] * gp + wg1[j] * Gv[m] + wg2[j] * gn + bg[j];
                        const float cvv = wv0[j] * vp + wv1[j] * Vv[m] + wv2[j] * vn + bv[j];
                        res[m][j] = siluf_(cgv) * cvv;
                    }
                    __builtin_amdgcn_sched_barrier(0);
                }
#pragma unroll
                for (int m = 0; m < 4; ++m) {
                    const int q = 16 * m + fr;
                    if (q >= 1 && q <= 62) {
                        u32x2 w; w.x = cvt_pk_bf16(res[m][0], res[m][1]); w.y = cvt_pk_bf16(res[m][2], res[m][3]);
                        *(GAS u32x2*)(a2g + (rowoff + (unsigned)(m * 16 * FF * 2 + n * 8))) = w;
                    }
                }
                __builtin_amdgcn_sched_barrier(0);
            }
        }
#pragma unroll
        for (int ai = 0; ai < 2; ++ai) {
            const int band = u.pm * 4 + wr + ai * 2;
            if (fr < 2) { const unsigned eo = (unsigned)((band * 4 + fr) * FF2 + ucol) * 4u + lo;
#pragma unroll
                for (int n = 0; n < 2; ++n) { *(GAS f32x4*)(edg + (eo + n * 16)) = acc[ai][0][0][n]; *(GAS f32x4*)(edg + (eo + FF * 4 + n * 16)) = acc[ai][1][0][n]; } }
            if (fr >= 14) { const unsigned eo = (unsigned)((band * 4 + fr - 12) * FF2 + ucol) * 4u + lo;
#pragma unroll
                for (int n = 0; n < 2; ++n) { *(GAS f32x4*)(edg + (eo + n * 16)) = acc[ai][0][3][n]; *(GAS f32x4*)(edg + (eo + FF * 4 + n * 16)) = acc[ai][1][3][n]; } }
        }
    }
};
}

__device__ __forceinline__ void transpose_item(const float* W, int K, int N, bf16_t* WT, int up_remap, float* scr, int item, int lane) {
    const int nblk = N / 64, kb = item / nblk, nb = item % nblk, k0 = 64 * kb, n0 = 64 * nb;
    const int kr = lane >> 4, c4 = lane & 15;
    f32x4 t[16];
#pragma unroll
    for (int i = 0; i < 16; ++i) t[i] = *(const f32x4*)(W + (size_t)(k0 + 4 * i + kr) * N + n0 + 4 * c4);
#pragma unroll
    for (int i = 0; i < 16; ++i) { float* sp = scr + (4 * i + kr) * 65 + 4 * c4; sp[0] = t[i][0]; sp[1] = t[i][1]; sp[2] = t[i][2]; sp[3] = t[i][3]; }
    asm volatile("s_waitcnt lgkmcnt(0)" ::: "memory");
    int rown0 = n0;
    if (up_remap) rown0 = n0 < FF ? (n0 / 128) * 256 + (n0 % 128) : ((n0 - FF) / 128) * 256 + 128 + ((n0 - FF) % 128);
    const int c = lane & 7;
#pragma unroll
    for (int j = 0; j < 8; ++j) { const int n = (lane >> 3) + 8 * j; const float* s = scr + (8 * c) * 65 + n;
        u32x4 o; o.x = pk2(s[0 * 65], s[1 * 65]); o.y = pk2(s[2 * 65], s[3 * 65]); o.z = pk2(s[4 * 65], s[5 * 65]); o.w = pk2(s[6 * 65], s[7 * 65]);
        *(u32x4*)(WT + (size_t)(rown0 + n) * K + k0 + 8 * c) = o; }
    asm volatile("s_waitcnt lgkmcnt(0)" ::: "memory");
}

__device__ __forceinline__ void phase0(const Params& P, unsigned char* lds, int tid, int lane, int wave, int bid, int G) {
    float* ada = (float*)(P.ws + WS_ADA);
    float* sc = (float*)lds; float* red = (float*)(lds + 40960);
    for (int item = bid; item < 192; item += G) {
        const int l = item / 96, n0 = (item % 96) * 128;
        for (int i = tid; i < 5 * DM; i += 512) { const int r = i >> 11, k = i & 2047; const float v = r < 4 ? P.c[r * DM + k] : P.c_ctx[k]; sc[i] = siluf_(v); }
        __syncthreads();
        const int c4 = tid & 31, kp = tid >> 5;
        f32x4 a0 = {0, 0, 0, 0}, a1 = a0, a2 = a0, a3 = a0, a4 = a0;
        const float* wp = P.w_ada + ((size_t)l * DM + kp * 128) * ADA_W + n0 + c4 * 4;
        const float* sp = sc + kp * 128;
#pragma unroll 8
        for (int kk = 0; kk < 128; ++kk) { const f32x4 w = *(const f32x4*)(wp + (size_t)kk * ADA_W);
            a0 += sp[kk] * w; a1 += sp[DM + kk] * w; a2 += sp[2 * DM + kk] * w; a3 += sp[3 * DM + kk] * w; a4 += sp[4 * DM + kk] * w; }
        *(f32x4*)(red + (kp * 5 + 0) * 128 + c4 * 4) = a0; *(f32x4*)(red + (kp * 5 + 1) * 128 + c4 * 4) = a1; *(f32x4*)(red + (kp * 5 + 2) * 128 + c4 * 4) = a2;
        *(f32x4*)(red + (kp * 5 + 3) * 128 + c4 * 4) = a3; *(f32x4*)(red + (kp * 5 + 4) * 128 + c4 * 4) = a4;
        __syncthreads();
        for (int o = tid; o < 640; o += 512) { const int r = o >> 7, col = o & 127; float s = 0.f;
#pragma unroll
            for (int k2 = 0; k2 < 16; ++k2) s += red[(k2 * 5 + r) * 128 + col];
            ada[(size_t)(l * 5 + r) * ADA_W + n0 + col] = s + P.b_ada[l * ADA_W + n0 + col]; }
        __syncthreads();
    }
    __syncthreads();
    float* scr = (float*)(lds + wave * 16896);
    const int gw = bid * 8 + wave, NGW = G * 8;
    constexpr int I_IN = 32 * 112, I_OUT = 32 * 32, I_UP = 32 * 176, I_DN = 88 * 32, I_L = I_IN + I_OUT + I_UP + I_DN;
    for (int it = gw; it < 2 * I_L; it += NGW) {
        const int l = it / I_L; int r = it % I_L;
        bf16_t* wt = (bf16_t*)(P.ws + WS_WT + (size_t)l * WT_LAYER);
        if (r < I_IN) { transpose_item(P.w_in + (size_t)l * DM * INW, DM, INW, wt, 0, scr, r, lane); continue; } r -= I_IN;
        if (r < I_OUT) { transpose_item(P.w_out + (size_t)l * DM * DM, DM, DM, (bf16_t*)((unsigned char*)wt + WT_OUT_OFF), 0, scr, r, lane); continue; } r -= I_OUT;
        if (r < I_UP) { transpose_item(P.w_up + (size_t)l * DM * FF2, DM, FF2, (bf16_t*)((unsigned char*)wt + WT_UP_OFF), 1, scr, r, lane); continue; } r -= I_UP;
        transpose_item(P.w_down + (size_t)l * FF * DM, FF, DM, (bf16_t*)((unsigned char*)wt + WT_DN_OFF), 0, scr, r, lane);
    }
}

__device__ __forceinline__ void phase_norm(bool XLB, const float* xl, const float* xc, const float* part, const float* lnw, const float* ada_l, int sh_idx, int nrows, bf16_t* HA, float* copy_c, int gw, int NGW, int lane) {
    for (int m0 = gw * 2; m0 < nrows; m0 += NGW * 2) {
        const int bsel = m0 < ML ? (m0 >> 12) : 4;
        const float* sh = ada_l + (size_t)bsel * ADA_W + sh_idx * DM; const float* scl = sh + DM;
        f32x4 v[2][8]; float ss[2] = {0.f, 0.f};
#pragma unroll
        for (int r = 0; r < 2; ++r) {
            if (XLB && m0 < ML) { const bf16_t* xb = (const bf16_t*)xl + (size_t)(m0 + r) * DM;
#pragma unroll
                for (int j = 0; j < 8; ++j) { const u32x2 w_ = *(const u32x2*)(xb + 256 * j + 4 * lane); v[r][j] = (f32x4){lo16(w_.x), hi16(w_.x), lo16(w_.y), hi16(w_.y)}; } }
            else { const float* xr = rowp(xl, xc, m0 + r);
#pragma unroll
                for (int j = 0; j < 8; ++j) v[r][j] = *(const f32x4*)(xr + 256 * j + 4 * lane); } }
        if (part && m0 >= ML) {
#pragma unroll
            for (int ks = 0; ks < 4; ++ks)
#pragma unroll
                for (int r = 0; r < 2; ++r)
#pragma unroll
                    for (int j = 0; j < 8; ++j) v[r][j] += *(const f32x4*)(part + (size_t)ks * ((size_t)MC * DM) + (size_t)(m0 - ML + r) * DM + 256 * j + 4 * lane); }
        if (copy_c && m0 >= ML) {
#pragma unroll
            for (int r = 0; r < 2; ++r)
#pragma unroll
                for (int j = 0; j < 8; ++j) *(f32x4*)(copy_c + (size_t)(m0 - ML + r) * DM + 256 * j + 4 * lane) = v[r][j]; }
#pragma unroll
        for (int r = 0; r < 2; ++r) {
#pragma unroll
            for (int j = 0; j < 8; ++j) ss[r] += v[r][j][0] * v[r][j][0] + v[r][j][1] * v[r][j][1] + v[r][j][2] * v[r][j][2] + v[r][j][3] * v[r][j][3];
            ss[r] = wave_sum(ss[r], lane); }
        const float rstd0 = rsqf_(ss[0] * (1.f / DM) + EPS), rstd1 = rsqf_(ss[1] * (1.f / DM) + EPS);
        bf16_t* orow = HA + (size_t)m0 * DM;
#pragma unroll
        for (int j = 0; j < 8; ++j) { const int col = 256 * j + 4 * lane;
            const f32x4 w = *(const f32x4*)(lnw + col), s = *(const f32x4*)(sh + col), c = *(const f32x4*)(scl + col);
            const f32x4 h0 = (v[0][j] * rstd0 * w) * (1.f + c) + s, h1 = (v[1][j] * rstd1 * w) * (1.f + c) + s;
            u32x2 o0, o1; o0.x = pk2(h0[0], h0[1]); o0.y = pk2(h0[2], h0[3]); o1.x = pk2(h1[0], h1[1]); o1.y = pk2(h1[2], h1[3]);
            *(u32x2*)(orow + col) = o0; *(u32x2*)(orow + DM + col) = o1; }
    }
}

__device__ __forceinline__ void hg_gates(const bf16_t* U, int base, int step, int zcol, float lbv, int pq, float (&lc)[16], float (&kk)[16]) {
    float run = 0.f;
#pragma unroll
    for (int i = 0; i < 16; ++i) { const int row = base + step * (pq * 16 + i);
        const float z = bf2f(U[(unsigned)(row * INW + zcol)]);
        const float e = __expf(-z), sg = rcpf_(1.f + e);
        const float f = lbv + (1.f - lbv) * sg;
        run += __logf(fmaxf(f, 1e-30f)); lc[i] = run; kk[i] = (1.f - lbv) * e * sg; }
}
__device__ __forceinline__ void hg_chunk_rows(int b, int dir, int c, int& base, int& step) {
    if (c < 4) base = ML + b * CTXL + (dir ? 255 - 64 * c : 64 * c);
    else base = b * SEQ + (dir ? 4095 - 64 * (c - 4) : 64 * (c - 4));
    step = dir ? -1 : 1;
}
__device__ __forceinline__ float hg_lb(const Params& P, int l, int dir, int idx) {
    if (l == 0) return 0.f;
    const float x0 = P.hg_lb[(dir * 2 + 0) * 512 + idx], x1 = P.hg_lb[(dir * 2 + 1) * 512 + idx];
    return rcpf_(1.f + __expf(x0 - x1));
}

__device__ __forceinline__ void hg_local_item(const Params& P, int l, const bf16_t* U, int item, unsigned char* lds, int tid) {
    const int s = item / NCHUNK, c = item % NCHUNK, dir = s & 1, h = (s >> 1) & 3, b = s >> 3;
    int base, step; hg_chunk_rows(b, dir, c, base, step);
    const int d = tid & 127, pq = tid >> 7, lane = tid & 63, wave = tid >> 6, fr = lane & 15, fq = lane >> 4;
    bf16_t* KT = (bf16_t*)lds; bf16_t* VT = (bf16_t*)(lds + 18432); float* PART = (float*)(lds + 36864);
    float* LT = (float*)(P.ws + WS_X1) + (size_t)item * 16384; float* DC = (float*)(P.ws + WS_DC) + (size_t)item * 128;
    const float lbv = hg_lb(P, l, dir, h * 128 + d);
    float lc[16], kk[16];
    bf16_t vraw[16];
#pragma unroll
    for (int i = 0; i < 16; ++i) vraw[i] = U[(unsigned)((base + step * (pq * 16 + i)) * INW + C_IV + h * 128 + d)];
    hg_gates(U, base, step, dir * 512 + h * 128 + d, lbv, pq, lc, kk);
    PART[pq * 128 + d] = lc[15];
    __syncthreads();
    const float p0 = PART[d], p1 = PART[128 + d], p2 = PART[256 + d], p3 = PART[384 + d];
    const float tot = p0 + p1 + p2 + p3;
    const float pre = pq == 0 ? 0.f : (pq == 1 ? p0 : (pq == 2 ? p0 + p1 : p0 + p1 + p2));
#pragma unroll
    for (int i = 0; i < 16; ++i) { const int pos = pq * 16 + i;
        KT[d * 72 + pos] = (bf16_t)f2bf(kk[i] * __expf(tot - (pre + lc[i])));
        VT[d * 72 + pos] = vraw[i]; }
    if (pq == 0) DC[d] = __expf(tot);
    __syncthreads();
    const int er = 16 * wave + fr;
    bf16x8 af[2];
#pragma unroll
    for (int ks = 0; ks < 2; ++ks) af[ks] = *(const bf16x8*)(VT + er * 72 + ks * 32 + fq * 8);
#pragma unroll
    for (int nt = 0; nt < 8; ++nt) { f32x4 acc = {0.f, 0.f, 0.f, 0.f};
#pragma unroll
        for (int ks = 0; ks < 2; ++ks) { const bf16x8 bfr = *(const bf16x8*)(KT + (16 * nt + fr) * 72 + ks * 32 + fq * 8); acc = MFMA16(af[ks], bfr, acc); }
#pragma unroll
        for (int j = 0; j < 4; ++j) LT[(16 * wave + fq * 4 + j) * 128 + 16 * nt + fr] = acc[j]; }
    __syncthreads();
}

__device__ __forceinline__ void hg_local_raw(const bf16_t* U, int item, int d, int pq, bf16_t (&zr)[16], bf16_t (&vr)[16]) {
    const int s = item / NCHUNK, c = item % NCHUNK, dir = s & 1, h = (s >> 1) & 3, b = s >> 3;
    int base, step; hg_chunk_rows(b, dir, c, base, step);
#pragma unroll
    for (int i = 0; i < 16; ++i) { const unsigned ro = (unsigned)((base + step * (pq * 16 + i)) * INW + h * 128 + d); zr[i] = U[ro + dir * 512]; vr[i] = U[ro + C_IV]; }
}
__device__ __forceinline__ void hg_local_static(const Params& P, int l, const bf16_t* U, int nitems, int bid, int G, unsigned char* lds, int tid) {
    const int d = tid & 127, pq = tid >> 7, lane = tid & 63, wave = tid >> 6, fr = lane & 15, fq = lane >> 4;
    bf16_t* KT = (bf16_t*)lds; bf16_t* VT = (bf16_t*)(lds + 18432); float* PART = (float*)(lds + 36864);
    bf16_t zr[16], vr[16];
    int item = bid;
    if (item < nitems) hg_local_raw(U, item, d, pq, zr, vr);
#pragma unroll 1
    while (item < nitems) {
        const int s = item / NCHUNK, dir = s & 1, h = (s >> 1) & 3;
        float* LT = (float*)(P.ws + WS_X1) + (size_t)item * 16384; float* DC = (float*)(P.ws + WS_DC) + (size_t)item * 128;
        const float lbv = hg_lb(P, l, dir, h * 128 + d);
        float lc[16], kk[16]; float run = 0.f;
#pragma unroll
        for (int i = 0; i < 16; ++i) { const float z = bf2f(zr[i]);
            const float e = __expf(-z), sg = rcpf_(1.f + e);
            const float f = lbv + (1.f - lbv) * sg;
            run += __logf(fmaxf(f, 1e-30f)); lc[i] = run; kk[i] = (1.f - lbv) * e * sg; }
        PART[pq * 128 + d] = run;
        __syncthreads();
        const float p0 = PART[d], p1 = PART[128 + d], p2 = PART[256 + d], p3 = PART[384 + d];
        const float tot = p0 + p1 + p2 + p3;
        const float pre = pq == 0 ? 0.f : (pq == 1 ? p0 : (pq == 2 ? p0 + p1 : p0 + p1 + p2));
#pragma unroll
        for (int i = 0; i < 16; ++i) { const int pos = pq * 16 + i;
            KT[d * 72 + pos] = (bf16_t)f2bf(kk[i] * __expf(tot - (pre + lc[i])));
            VT[d * 72 + pos] = vr[i]; }
        if (pq == 0) DC[d] = __expf(tot);
        const int nitem = item + G;
        if (nitem < nitems) hg_local_raw(U, nitem, d, pq, zr, vr);
        __syncthreads();
        const int er = 16 * wave + fr;
        bf16x8 af[2];
#pragma unroll
        for (int ks = 0; ks < 2; ++ks) af[ks] = *(const bf16x8*)(VT + er * 72 + ks * 32 + fq * 8);
#pragma unroll
        for (int nt = 0; nt < 8; ++nt) { f32x4 acc = {0.f, 0.f, 0.f, 0.f};
#pragma unroll
            for (int ks = 0; ks < 2; ++ks) { const bf16x8 bfr = *(const bf16x8*)(KT + (16 * nt + fr) * 72 + ks * 32 + fq * 8); acc = MFMA16(af[ks], bfr, acc); }
#pragma unroll
            for (int j = 0; j < 4; ++j) LT[(16 * wave + fq * 4 + j) * 128 + 16 * nt + fr] = acc[j]; }
        __syncthreads();
        item = nitem;
    }
}

__device__ __forceinline__ void hg_scan(const Params& P, int tid, int bid, int G) {
    const float* LT = (const float*)(P.ws + WS_X1); const float* DC = (const float*)(P.ws + WS_DC); bf16_t* ST = (bf16_t*)(P.ws + WS_HA);
    for (int idx = bid * 512 + tid; idx < 32 * 4096; idx += G * 512) {
        const int s = idx >> 12, off4 = idx & 4095, d4 = off4 & 31;
        f32x4 S = {0.f, 0.f, 0.f, 0.f};
        const float* Lp = LT + (size_t)s * NCHUNK * 16384 + off4 * 4; const float* Dp = DC + (size_t)s * NCHUNK * 128 + d4 * 4;
        bf16_t* Sp = ST + (size_t)s * NCHUNK * 16384 + off4 * 4;
        f32x4 Lc[8], Dc[8], Ln[8], Dn[8];
#pragma unroll
        for (int k = 0; k < 8; ++k) { Lc[k] = *(const f32x4*)(Lp + (size_t)k * 16384); Dc[k] = *(const f32x4*)(Dp + k * 128); }
#pragma unroll 1
        for (int c0 = 0; c0 < NCHUNK; c0 += 8) {
#pragma unroll
            for (int k = 0; k < 8; ++k) if (c0 + 8 + k < NCHUNK) { Ln[k] = *(const f32x4*)(Lp + (size_t)(c0 + 8 + k) * 16384); Dn[k] = *(const f32x4*)(Dp + (c0 + 8 + k) * 128); }
#pragma unroll
            for (int k = 0; k < 8; ++k) if (c0 + k < NCHUNK) { u32x2 o; o.x = pk2(S[0], S[1]); o.y = pk2(S[2], S[3]);
                *(u32x2*)(Sp + (size_t)(c0 + k) * 16384) = o;
                S = Dc[k] * S + Lc[k]; }
#pragma unroll
            for (int k = 0; k < 8; ++k) { Lc[k] = Ln[k]; Dc[k] = Dn[k]; }
        }
    }
}

__device__ __forceinline__ void hg_out_item(const Params& P, int l, const bf16_t* U, bf16_t* MIX, int b, int h, int pc, unsigned char* lds, int tid) {
    const int d = tid & 127, pq = tid >> 7, lane = tid & 63, wave = tid >> 6, fr = lane & 15, fq = lane >> 4;
    bf16_t* QT = (bf16_t*)lds; bf16_t* QH = (bf16_t*)(lds + 17408); bf16_t* KH = (bf16_t*)(lds + 34816); bf16_t* VT = (bf16_t*)(lds + 78336);
    bf16_t* ATT = (bf16_t*)(lds + 96768); float* OS = (float*)(lds + 105984); float* PART = (float*)(lds + 139776);
    const bf16_t* ST = (const bf16_t*)(P.ws + WS_HA);
#pragma unroll 1
    for (int dir = 0; dir < 2; ++dir) {
        const int c = dir == 0 ? pc : (pc < 4 ? 3 - pc : 71 - pc);
        int base, step; hg_chunk_rows(b, dir, c, base, step);
        const size_t item = (size_t)((b * 4 + h) * 2 + dir) * NCHUNK + c;
        const float lbv = hg_lb(P, l, dir, h * 128 + d);
        float lc[16], kk[16];
        bf16x8 stf[4][4];
        { const bf16_t* STc = ST + item * 16384; const int ntb0 = (wave >> 2) * 4;
#pragma unroll
          for (int ks = 0; ks < 4; ++ks)
#pragma unroll
              for (int t = 0; t < 4; ++t) stf[ks][t] = *(const bf16x8*)(STc + (16 * (ntb0 + t) + fr) * 128 + ks * 32 + fq * 8); }
        bf16_t vraw[16], qraw[16];
#pragma unroll
        for (int i = 0; i < 16; ++i) { const unsigned ro = (unsigned)((base + step * (pq * 16 + i)) * INW + h * 128 + d); vraw[i] = U[ro + C_IV]; qraw[i] = U[ro + C_HGQ]; }
        hg_gates(U, base, step, dir * 512 + h * 128 + d, lbv, pq, lc, kk);
        PART[pq * 128 + d] = lc[15];
        __syncthreads();
        const float p0 = PART[d], p1 = PART[128 + d], p2 = PART[256 + d];
        const float ref1 = p0, ref2 = p0 + p1, ref3 = p0 + p1 + p2;
        const float myref = pq == 0 ? 0.f : (pq == 1 ? ref1 : (pq == 2 ? ref2 : ref3));
        const float gref = __expf(myref);
        float fI[4];
#pragma unroll
        for (int I = 0; I < 4; ++I) { const float refI = I == 0 ? 0.f : (I == 1 ? ref1 : (I == 2 ? ref2 : ref3)); fI[I] = __expf(fminf(refI - myref, 0.f)); }
#pragma unroll
        for (int i = 0; i < 16; ++i) { const int pos = pq * 16 + i;
            const float qv = siluf_(bf2f(qraw[i]));
            const float el = __expf(lc[i]), eln = __expf(fminf(-lc[i], 80.f));
            const float qh = qv * el, kh = kk[i] * eln;
            QT[pos * 136 + d] = (bf16_t)f2bf(qh * gref);
            QH[pos * 136 + d] = (bf16_t)f2bf(qh);
#pragma unroll
            for (int I = 0; I < 4; ++I) if (I >= pq) KH[(8 * I * (I + 1) + pos) * 136 + d] = (bf16_t)f2bf(kh * fI[I]);
            VT[d * 72 + pos] = vraw[i]; }
        __syncthreads();
        const int I = wave & 3, half = wave >> 2;
        {
            bf16x8 aq[4];
#pragma unroll
            for (int ks = 0; ks < 4; ++ks) aq[ks] = *(const bf16x8*)(QH + (16 * I + fr) * 136 + ks * 32 + fq * 8);
#pragma unroll
            for (int jj = 0; jj < 2; ++jj) { const int J = half + 2 * jj;
                f32x4 acc = {0.f, 0.f, 0.f, 0.f};
                if (J <= I) {
#pragma unroll
                    for (int ks = 0; ks < 4; ++ks) { const bf16x8 bk = *(const bf16x8*)(KH + (8 * I * (I + 1) + 16 * J + fr) * 136 + ks * 32 + fq * 8); acc = MFMA16(aq[ks], bk, acc); }
                }
#pragma unroll
                for (int j = 0; j < 4; ++j) { const int ii = 16 * I + fq * 4 + j, jc = 16 * J + fr;
                    const float v = (J <= I && jc <= ii) ? acc[j] : 0.f;
                    ATT[ii * 72 + jc] = (bf16_t)f2bf(v); } }
        }
        __syncthreads();
        {
            f32x4 o[4];
#pragma unroll
            for (int t = 0; t < 4; ++t) o[t] = (f32x4){0.f, 0.f, 0.f, 0.f};
            const int ntb = half * 4;
#pragma unroll
            for (int ks = 0; ks < 4; ++ks) { const bf16x8 a = *(const bf16x8*)(QT + (16 * I + fr) * 136 + ks * 32 + fq * 8);
#pragma unroll
                for (int t = 0; t < 4; ++t) o[t] = MFMA16(a, stf[ks][t], o[t]); }
            const int nks = (I + 2) >> 1;
#pragma unroll
            for (int ks = 0; ks < 2; ++ks) if (ks < nks) { const bf16x8 a = *(const bf16x8*)(ATT + (16 * I + fr) * 72 + ks * 32 + fq * 8);
#pragma unroll
                for (int t = 0; t < 4; ++t) { const bf16x8 bv = *(const bf16x8*)(VT + (16 * (ntb + t) + fr) * 72 + ks * 32 + fq * 8); o[t] = MFMA16(a, bv, o[t]); } }
#pragma unroll
            for (int t = 0; t < 4; ++t)
#pragma unroll
                for (int j = 0; j < 4; ++j) { const int ii = 16 * I + fq * 4 + j, pl = dir ? 63 - ii : ii, e = 16 * (ntb + t) + fr;
                    if (dir == 0) OS[pl * 132 + e] = o[t][j]; else OS[pl * 132 + e] += o[t][j]; }
        }
        __syncthreads();
    }
    const int rowbase = pc < 4 ? ML + b * CTXL + 64 * pc : b * SEQ + 64 * (pc - 4);
    const float w0 = P.hg_norm_w[l * 128 + 2 * lane], w1 = P.hg_norm_w[l * 128 + 2 * lane + 1];
#pragma unroll 2
    for (int i = 0; i < 8; ++i) { const int pl = wave * 8 + i, row = rowbase + pl;
        const float o0 = OS[pl * 132 + 2 * lane], o1 = OS[pl * 132 + 2 * lane + 1];
        const float ss = wave_sum(o0 * o0 + o1 * o1, lane);
        const float rstd = rsqf_(ss * (1.f / 128.f) + EPS);
        const unsigned gw2 = *(const unsigned*)(U + (unsigned)(row * INW + C_HGG + h * 128 + 2 * lane));
        const float g0 = lo16(gw2), g1 = hi16(gw2);
        *(unsigned*)(MIX + (size_t)row * DM + h * 128 + 2 * lane) = pk2(o0 * rstd * w0 * siluf_(g0), o1 * rstd * w1 * siluf_(g1)); }
    __syncthreads();
}

__device__ __forceinline__ void na_item(const Params& P, int l, const bf16_t* U, bf16_t* MIX, int qrow0, int b, int r0, int hp, bool local, unsigned char* lds, int tid) {
    const int lane = tid & 63, wave = tid >> 6, hh = wave >> 2, qb = wave & 3, h = hp * 2 + hh, fr = lane & 15, fq = lane >> 4;
    bf16_t* Kt = (bf16_t*)lds + hh * (64 * 136);
    bf16_t* Vn = (bf16_t*)(lds + 34816) + hh * (64 * 144);
    bf16_t* Pw = (bf16_t*)(lds + 71680) + wave * (32 * 72);
    float* RPB = (float*)(lds + 108544);
    float* KS = (float*)(lds + 112640) + hh * 64;
    const int rsA = min(max(r0 - 4, 0), 56), rsB = min(max(r0 - 3, 0), 56);
    const int nloc = local ? 8 + (rsB - rsA) : 0, ntile = nloc + 4;
    if (local) for (int i = tid; i < 2 * 465; i += 512) { const int h2 = i / 465, k = i % 465; RPB[h2 * 480 + k] = P.rpb[(size_t)((l * 8 + hp * 2 + h2) * 465) + k]; }
    const int tg = tid & 255;
    u32x4 kraw[4], vraw[4];
#define NA_LOAD(KT) do { _Pragma("unroll") for (int i = 0; i < 4; ++i) { const int pid = tg + 256 * i, key = pid >> 4, pc = pid & 15; \
        const int krow = (KT) < nloc ? b * SEQ + (rsA + (KT)) * 64 + key : ML + b * CTXL + ((KT) - nloc) * 64 + key; \
        const bf16_t* up = U + (unsigned)(krow * INW + h * 128 + pc * 8); kraw[i] = *(const u32x4*)(up + C_NAK); vraw[i] = *(const u32x4*)(up + C_NAV); } } while (0)
    NA_LOAD(0);
    bf16x8 qf[2][4];
    {
        const float* qw = P.q_norm_w + l * 128; const float* kw = P.k_norm_w + l * 128;
#pragma unroll
        for (int q2 = 0; q2 < 2; ++q2) {
            const bf16_t* qp = U + (unsigned)((qrow0 + q2 * 64 + qb * 16 + fr) * INW + C_NAQ + h * 128 + fq * 8);
            float qv[4][8]; float ss = 0.f;
#pragma unroll
            for (int ks = 0; ks < 4; ++ks) { unpack8(*(const u32x4*)(qp + ks * 32), qv[ks]);
#pragma unroll
                for (int e = 0; e < 8; ++e) ss += qv[ks][e] * qv[ks][e]; }
            ss += xshfl(ss, 16, lane); ss += xshfl(ss, 32, lane);
            const float rstd = rsqf_(ss * (1.f / 128.f) + EPS) * ATTN_SCALE;
#pragma unroll
            for (int ks = 0; ks < 4; ++ks) { const int d0 = ks * 32 + fq * 8; float t[8];
#pragma unroll
                for (int e = 0; e < 8; ++e) t[e] = qv[ks][e] * rstd * qw[d0 + e] * kw[d0 + e];
                u32x4 w; w.x = pk2(t[0], t[1]); w.y = pk2(t[2], t[3]); w.z = pk2(t[4], t[5]); w.w = pk2(t[6], t[7]);
                qf[q2][ks] = as_frag(w); }
        }
    }
    f32x4 O[2][8];
    float mrow[2][4], lrow[2][4];
#pragma unroll
    for (int q2 = 0; q2 < 2; ++q2) {
#pragma unroll
        for (int nt = 0; nt < 8; ++nt) O[q2][nt] = (f32x4){0.f, 0.f, 0.f, 0.f};
#pragma unroll
        for (int j = 0; j < 4; ++j) { mrow[q2][j] = -3e38f; lrow[q2][j] = 0.f; } }
    const LAS bf16_t* vtr = (const LAS bf16_t*)Vn + (8 * fq + (fr >> 2)) * 144 + 4 * (fr & 3);
#pragma unroll 1
    for (int kt = 0; kt < ntile; ++kt) {
#pragma unroll
        for (int i = 0; i < 4; ++i) { const int pid = tg + 256 * i, key = pid >> 4, pc = pid & 15;
            float kf[8]; unpack8(kraw[i], kf); float ss = 0.f;
#pragma unroll
            for (int e = 0; e < 8; ++e) ss += kf[e] * kf[e];
            ss = sum16d(ss);
            if (pc == 0) KS[key] = rsqf_(ss * (1.f / 128.f) + EPS);
            *(u32x4*)(Kt + key * 136 + pc * 8) = kraw[i];
            *(u32x4*)(Vn + key * 144 + pc * 8) = vraw[i]; }
        __syncthreads();
        if (kt + 1 < ntile) NA_LOAD(kt + 1);
        const bool isloc = kt < nloc;
        const int kr = rsA + kt;
        const bool val0 = !isloc || (kr < rsA + 8), val1 = !isloc || (kr >= rsB);
        f32x4 s[2][4];
#pragma unroll
        for (int nt = 0; nt < 4; ++nt) { s[0][nt] = (f32x4){0.f, 0.f, 0.f, 0.f}; s[1][nt] = (f32x4){0.f, 0.f, 0.f, 0.f};
            if (!isloc || (nt >= qb - 1 && nt <= qb + 1)) {
#pragma unroll
            for (int ks = 0; ks < 4; ++ks) { const bf16x8 bk = *(const bf16x8*)(Kt + (16 * nt + fr) * 136 + ks * 32 + fq * 8);
                if (val0) s[0][nt] = MFMA16(qf[0][ks], bk, s[0][nt]);
                if (val1) s[1][nt] = MFMA16(qf[1][ks], bk, s[1][nt]); }
            const float kscale = KS[16 * nt + fr];
#pragma unroll
            for (int j = 0; j < 4; ++j) { s[0][nt][j] *= kscale; s[1][nt][j] *= kscale; } } }
#pragma unroll
        for (int q2 = 0; q2 < 2; ++q2) {
            const bool val = q2 ? val1 : val0;
            if (val) {
                if (isloc) {
                    const int ir = kr - (r0 + q2) + 7;
#pragma unroll
                    for (int nt = 0; nt < 4; ++nt) {
                        if (nt >= qb - 1 && nt <= qb + 1) {
#pragma unroll
                        for (int j = 0; j < 4; ++j) { const int xq = qb * 16 + fq * 4 + j, kc = nt * 16 + fr;
                            const int wsx = min(max(xq - 8, 0), 48);
                            const bool ok = (kc >= wsx) && (kc < wsx + 16);
                            const int ic = min(max(kc - xq + 15, 0), 30);
                            s[q2][nt][j] = ok ? s[q2][nt][j] + RPB[hh * 480 + ir * 31 + ic] : -1e30f; }
                        } else s[q2][nt] = (f32x4){-1e30f, -1e30f, -1e30f, -1e30f}; }
                }
                float mxj[4]; bool need = false;
#pragma unroll
                for (int j = 0; j < 4; ++j) { float mx = fmaxf(fmaxf(s[q2][0][j], s[q2][1][j]), fmaxf(s[q2][2][j], s[q2][3][j])); mxj[j] = max16d(mx); need = need || (mxj[j] > mrow[q2][j] + 8.f); }
                if (__builtin_amdgcn_ballot_w64(need) != 0ull) {
                    float alpha[4];
#pragma unroll
                    for (int j = 0; j < 4; ++j) { const bool up = mxj[j] > mrow[q2][j] + 8.f; alpha[j] = up ? __expf(mrow[q2][j] - mxj[j]) : 1.f; mrow[q2][j] = up ? mxj[j] : mrow[q2][j]; lrow[q2][j] *= alpha[j]; }
#pragma unroll
                    for (int nt = 0; nt < 8; ++nt)
#pragma unroll
                        for (int j = 0; j < 4; ++j) O[q2][nt][j] *= alpha[j];
                }
#pragma unroll
                for (int j = 0; j < 4; ++j) { const float mn = mrow[q2][j]; float rsum = 0.f;
#pragma unroll
                    for (int nt = 0; nt < 4; ++nt) { const float pv = s[q2][nt][j] > -1e29f ? __expf(s[q2][nt][j] - mn) : 0.f; s[q2][nt][j] = pv; rsum += pv; }
                    rsum = sum16d(rsum); lrow[q2][j] += rsum; }
#pragma unroll
                for (int nt = 0; nt < 4; ++nt)
#pragma unroll
                    for (int j = 0; j < 4; ++j) Pw[(q2 * 16 + fq * 4 + j) * 72 + nt * 16 + fr] = (bf16_t)f2bf(s[q2][nt][j]);
            }
        }
        asm volatile("s_waitcnt lgkmcnt(0)" ::: "memory");
#pragma unroll
        for (int ks = 0; ks < 2; ++ks) { const bf16x8 a0 = *(const bf16x8*)(Pw + fr * 72 + ks * 32 + fq * 8), a1 = *(const bf16x8*)(Pw + (16 + fr) * 72 + ks * 32 + fq * 8);
#pragma unroll
            for (int nt = 0; nt < 8; ++nt) {
                const s16x4 v0 = __builtin_amdgcn_ds_read_tr16_b64_v4i16((LAS s16x4*)(vtr + (32 * ks) * 144 + 16 * nt));
                const s16x4 v1 = __builtin_amdgcn_ds_read_tr16_b64_v4i16((LAS s16x4*)(vtr + (32 * ks + 4) * 144 + 16 * nt));
                const bf16x8 bv = __builtin_shufflevector(v0, v1, 0, 1, 2, 3, 4, 5, 6, 7);
                if (val0) O[0][nt] = MFMA16(a0, bv, O[0][nt]);
                if (val1) O[1][nt] = MFMA16(a1, bv, O[1][nt]); } }
        __syncthreads();
    }
#undef NA_LOAD
    const float* ow = P.na_onorm + l * 1024 + h * 128;
#pragma unroll
    for (int q2 = 0; q2 < 2; ++q2)
#pragma unroll
        for (int j = 0; j < 4; ++j) { const float inv = rcpf_(lrow[q2][j]); float ss = 0.f;
#pragma unroll
            for (int nt = 0; nt < 8; ++nt) { const float v = O[q2][nt][j] * inv; ss += v * v; }
            ss = sum16d(ss);
            const float sc = rsqf_(ss * (1.f / 128.f) + EPS) * inv;
            bf16_t* op = MIX + (size_t)(qrow0 + q2 * 64 + qb * 16 + fq * 4 + j) * DM + 512 + h * 128;
#pragma unroll
            for (int nt = 0; nt < 8; ++nt) op[16 * nt + fr] = (bf16_t)f2bf(O[q2][nt][j] * sc * ow[16 * nt + fr]); }
}

__device__ __forceinline__ void cv_rows8(const Params& P, int l, const bf16_t* U, bf16_t* MIX, int t0, int lane) {
    int pos, len; if (t0 < ML) { pos = t0 & (SEQ - 1); len = SEQ; } else { pos = (t0 - ML) & (CTXL - 1); len = CTXL; }
    const int ch = lane * 8;
    const bf16_t* up = U + (size_t)t0 * INW + ch;
    const bool hasp = pos > 0, hasn = pos + 8 < len;
    const u32x4 z4 = {0u, 0u, 0u, 0u};
    u32x4 rc[10], rv[10], rb[8];
#pragma unroll
    for (int r = 0; r < 10; ++r) { const bool ok = (r == 0) ? hasp : ((r == 9) ? hasn : true);
        rc[r] = ok ? *(const u32x4*)(up + (ptrdiff_t)(r - 1) * INW + C_CVC) : z4; rv[r] = ok ? *(const u32x4*)(up + (ptrdiff_t)(r - 1) * INW + C_CVV) : z4; }
#pragma unroll
    for (int r = 0; r < 8; ++r) rb[r] = *(const u32x4*)(up + (size_t)r * INW + C_CVB);
    const float* w = P.cv_w + (size_t)l * 3 * 512 + ch; const float* ow = P.cv_onorm + l * 512 + ch;
    float w0[8], w1[8], w2[8], on[8];
#pragma unroll
    for (int e = 0; e < 8; ++e) { w0[e] = w[e]; w1[e] = w[512 + e]; w2[e] = w[1024 + e]; on[e] = ow[e]; }
    float pp[8], pc[8], pn[8], a[8], b[8];
    unpack8(rc[0], a); unpack8(rv[0], b);
#pragma unroll
    for (int e = 0; e < 8; ++e) pp[e] = a[e] * b[e];
    unpack8(rc[1], a); unpack8(rv[1], b);
#pragma unroll
    for (int e = 0; e < 8; ++e) pc[e] = a[e] * b[e];
#pragma unroll
    for (int r = 0; r < 8; ++r) {
        unpack8(rc[r + 2], a); unpack8(rv[r + 2], b);
#pragma unroll
        for (int e = 0; e < 8; ++e) pn[e] = a[e] * b[e];
        float bg[8]; unpack8(rb[r], bg);
        float y[8]; float ss = 0.f;
#pragma unroll
        for (int e = 0; e < 8; ++e) { y[e] = bg[e] * (w0[e] * pp[e] + w1[e] * pc[e] + w2[e] * pn[e]); ss += y[e] * y[e]; }
        ss = sum16d(ss);
        const float rstd = rsqf_(ss * (1.f / 128.f) + EPS);
        u32x4 o; o.x = pk2(y[0] * rstd * on[0], y[1] * rstd * on[1]); o.y = pk2(y[2] * rstd * on[2], y[3] * rstd * on[3]);
        o.z = pk2(y[4] * rstd * on[4], y[5] * rstd * on[5]); o.w = pk2(y[6] * rstd * on[6], y[7] * rstd * on[7]);
        *(u32x4*)(MIX + (size_t)(t0 + r) * DM + 1536 + ch) = o;
#pragma unroll
        for (int e = 0; e < 8; ++e) { pp[e] = pc[e]; pc[e] = pn[e]; }
    }
}

__device__ __forceinline__ void phase_fix(const float* EDGE, bf16_t* A2, const float* cw, const float* cb, int nbands, int gw, int NGW, int lane) {
    for (int it = gw; it < nbands * 2 * 8; it += NGW) {
        const int seg = it & 7, rr = it >> 3;
        const int band = rr >> 1, lastr = rr & 1, r = band * 64 + (lastr ? 63 : 0);
        int pos, len; if (r < ML) { pos = r & (SEQ - 1); len = SEQ; } else { pos = (r - ML) & (CTXL - 1); len = CTXL; }
        const bool hasp = pos > 0, hasn = pos < len - 1;
        const float* ec = EDGE + (size_t)(band * 4 + (lastr ? 3 : 0)) * FF2;
        const float* ep = ec - FF2; const float* en = ec + FF2;
        const f32x4 z4 = {0.f, 0.f, 0.f, 0.f};
#pragma unroll
        for (int k = 0; k < 3; ++k) { const int c4 = seg * 176 + k * 64 + lane;
            if (k * 64 + lane < 176) { const int col = c4 * 4;
                const f32x4 gp = hasp ? *(const f32x4*)(ep + col) : z4, gc = *(const f32x4*)(ec + col), gn = hasn ? *(const f32x4*)(en + col) : z4;
                const f32x4 vp = hasp ? *(const f32x4*)(ep + FF + col) : z4, vc = *(const f32x4*)(ec + FF + col), vn = hasn ? *(const f32x4*)(en + FF + col) : z4;
                const f32x4 cg = *(const f32x4*)(cw + col) * gp + *(const f32x4*)(cw + FF2 + col) * gc + *(const f32x4*)(cw + 2 * FF2 + col) * gn + *(const f32x4*)(cb + col);
                const f32x4 cv = *(const f32x4*)(cw + FF + col) * vp + *(const f32x4*)(cw + FF2 + FF + col) * vc + *(const f32x4*)(cw + 2 * FF2 + FF + col) * vn + *(const f32x4*)(cb + FF + col);
                u32x2 o; o.x = pk2(siluf_(cg[0]) * cv[0], siluf_(cg[1]) * cv[1]); o.y = pk2(siluf_(cg[2]) * cv[2], siluf_(cg[3]) * cv[3]);
                *(u32x2*)(A2 + (size_t)r * FF + col) = o; } }
    }
}

#define XB_TMO      128
#define XB_XCNT(j)  (256  + 64 * (j))
#define XB_XSUB(j)  (1280 + 64 * (j))
#define XB_XGEN(j)  (2304 + 64 * (j))
#define XB_TOP      3328
#define XB_TOPGEN   3392
#define XCD_BAR_WORDS 3456
#define XB_SPIN_CAP (1u << 18)

__device__ __forceinline__ unsigned xb_ld(unsigned* p)              { return __hip_atomic_load(p, __ATOMIC_RELAXED, __HIP_MEMORY_SCOPE_AGENT); }
__device__ __forceinline__ unsigned xb_add(unsigned* p, unsigned v) { return __hip_atomic_fetch_add(p, v, __ATOMIC_RELAXED, __HIP_MEMORY_SCOPE_AGENT); }
__device__ __forceinline__ unsigned xb_xcc_id() { return (unsigned)__builtin_amdgcn_s_getreg((3 << 11) | 20) & 0xFu; }
#define XB_SPIN(cond, bar) do { unsigned _sp = 0; while (cond) { __builtin_amdgcn_s_sleep(1); \
    if ((++_sp & 255u) == 0u) { if (xb_ld(&(bar)[XB_TMO])) break; if (_sp > XB_SPIN_CAP) { atomicAdd(&(bar)[XB_TMO], 1u); break; } } } } while (0)

struct XcdBarrier {
    unsigned* bar; unsigned x;
    volatile LAS unsigned* st;
};

__device__ __forceinline__ XcdBarrier xcd_barrier_post(unsigned* bar, volatile LAS unsigned* st) {
    XcdBarrier b; b.bar = bar; b.x = xb_xcc_id(); b.st = st;
    if (threadIdx.x == 0) (void)xb_add(&bar[XB_XCNT(b.x)], 1u);
    return b;
}
__device__ __forceinline__ void xcd_barrier_complete(unsigned* bar, unsigned x, unsigned& nloc, unsigned& nx) {
    const unsigned G = gridDim.x * gridDim.y * gridDim.z;
    unsigned sum, cnt, mine, sp = 0u;
    for (;;) {
        sum = 0u; cnt = 0u; mine = 0u;
#pragma unroll
        for (unsigned j = 0; j < 16; ++j) { const unsigned c = xb_ld(&bar[XB_XCNT(j)]); sum += c; cnt += (c > 0u) ? 1u : 0u; mine = (j == x) ? c : mine; }
        if (sum == G) break;
        __builtin_amdgcn_s_sleep(1);
        if ((++sp & 255u) == 0u) { if (xb_ld(&bar[XB_TMO])) break; if (sp > XB_SPIN_CAP) { atomicAdd(&bar[XB_TMO], 1u); break; } }
    }
    nloc = mine > 0u ? mine : 1u; nx = cnt > 0u ? cnt : 1u;
}

__device__ __forceinline__ void xcd_barrier(const XcdBarrier& b) {
    asm volatile("s_waitcnt vmcnt(0)" ::: "memory");
    __syncthreads();
    if (threadIdx.x == 0) {
        unsigned* bar = b.bar;
        __builtin_amdgcn_s_waitcnt(0);
        unsigned nloc = b.st[0], nx = b.st[1];
        if (nloc == 0u) { xcd_barrier_complete(bar, b.x, nloc, nx); b.st[0] = nloc; b.st[1] = nx; }
        const unsigned old = xb_add(&bar[XB_XSUB(b.x)], 1u);
        const unsigned gen = old / nloc;
        if (old + 1u == (gen + 1u) * nloc) {
            __builtin_amdgcn_fence(__ATOMIC_RELEASE, "agent");
            asm volatile("s_waitcnt vmcnt(0)" ::: "memory");
            const unsigned og = xb_add(&bar[XB_TOP], 1u);
            const unsigned tg = og / nx;
            if (og + 1u == (tg + 1u) * nx) xb_add(&bar[XB_TOPGEN], 1u);
            else XB_SPIN(xb_ld(&bar[XB_TOPGEN]) == tg, bar);
            __builtin_amdgcn_fence(__ATOMIC_ACQUIRE, "agent");
            xb_add(&bar[XB_XGEN(b.x)], 1u);
            asm volatile("s_waitcnt vmcnt(0)" ::: "memory");
        } else {
            XB_SPIN(xb_ld(&bar[XB_XGEN(b.x)]) == gen, bar);
            __builtin_amdgcn_fence(__ATOMIC_ACQUIRE, "agent");
            asm volatile("s_waitcnt vmcnt(0)" ::: "memory");
        }
    }
    __syncthreads();
}

__device__ __forceinline__ Params load_params() {
    Params r;
#if defined(__HIP_DEVICE_COMPILE__)
    typedef const __attribute__((address_space(4))) unsigned long long* U64CP;
    U64CP p = (U64CP)__builtin_amdgcn_kernarg_segment_ptr();
    asm volatile("" : "+s"(p));
    const float** d = (const float**)&r;
#pragma unroll
    for (int i = 0; i < (int)(sizeof(Params) / 8); ++i) d[i] = (const float*)(const GAS float*)(p[i]);
#endif
    return r;
}
#define PHASE_BEGIN const Params P = load_params(); const int lane = (int)__builtin_amdgcn_mbcnt_hi(~0u, __builtin_amdgcn_mbcnt_lo(~0u, (unsigned)opaque_s(0))), wave = opaque_s(wave_s), tid = wave * 64 + lane; \
    const int bid = opaque_s(blockIdx.x), G = opaque_s(gridDim.x), gw = bid * 8 + wave, NGW = G * 8; unsigned char* ws = P.ws; \
    (void)lane; (void)gw; (void)NGW; (void)ws;
#ifndef REP_MASK
#define REP_MASK 0
#endif
#define REP(bit) for (int rep_ = 0; rep_ < (((REP_MASK) >> (bit)) & 1) + 1; ++rep_)
#ifndef SYNC_REP
#define SYNC_REP 1
#endif
#define GSYNC do { for (int sr_ = 0; sr_ < SYNC_REP; ++sr_) { const Params Pb_ = load_params(); XcdBarrier xb_; xb_.bar = (unsigned*)(Pb_.ws + WS_BAR); xb_.x = xb_xcc_id(); xb_.st = (volatile LAS unsigned*)(ldsl + (LDS_BYTES - 16)); xcd_barrier(xb_); } } while (0)
#define DYN_LOOP_BEGIN(CTRIDX, NITEMS) { unsigned* ctr_ = (unsigned*)(ws + WS_CTR) + (CTRIDX) * 64; volatile LAS unsigned* slot_ = (volatile LAS unsigned*)(ldsl + (LDS_BYTES - 32)); \
    int it = bid; while (it < (NITEMS)) { unsigned nx_ = 0u; if (tid_ == 0) nx_ = __hip_atomic_fetch_add(ctr_, 1u, __ATOMIC_RELAXED, __HIP_MEMORY_SCOPE_AGENT) + (unsigned)G;
#define DYN_LOOP_END __syncthreads(); if (tid_ == 0) slot_[0] = nx_; __syncthreads(); it = (int)slot_[0]; __syncthreads(); } }
#define ADA_L ((const float*)(ws + WS_ADA) + (size_t)l * 5 * ADA_W)
#define WT_L (ws + WS_WT + (size_t)l * WT_LAYER)

__global__ void __launch_bounds__(512, 2) mega(Params Pk) {
    extern __shared__ __attribute__((aligned(16))) unsigned char lds[];
    cg::grid_group grid = cg::this_grid();
    LAS unsigned char* ldsl = (LAS unsigned char*)lds;
    const int wave_s = __builtin_amdgcn_readfirstlane((int)threadIdx.x >> 6);
    { PHASE_BEGIN
      if (bid == 0) { for (int i = tid; i < XCD_BAR_WORDS; i += 512) ((unsigned*)(ws + WS_BAR))[i] = 0u;
                      if (tid < 8) ((unsigned*)(ws + WS_CTR))[tid * 64] = 0u; }
      if (tid < 4) ((volatile LAS unsigned*)(ldsl + (LDS_BYTES - 16)))[tid] = 0u; }
    REP(0) { { PHASE_BEGIN phase0(P, lds, tid, lane, wave, bid, G); }
    grid.sync(); }
    { PHASE_BEGIN (void)xcd_barrier_post((unsigned*)(ws + WS_BAR), (volatile LAS unsigned*)(ldsl + (LDS_BYTES - 16))); }
#pragma unroll 1
    for (int l = 0; l < 2; ++l) {
        const bool lastl = (l == 1);
        REP(1) { { PHASE_BEGIN
          const float* xin_l = lastl ? (const float*)(ws + WS_X2B) : P.x; const float* xin_c = lastl ? (const float*)(ws + WS_X1) + (size_t)ML * DM : P.ctx;
          phase_norm(lastl, xin_l, xin_c, lastl ? (const float*)(ws + WS_PART) : nullptr, P.ln1_w + l * DM, ADA_L, 0, MA, (bf16_t*)(ws + WS_HA), nullptr, gw, NGW, lane); }
        GSYNC; }
        REP(2) { { PHASE_BEGIN
          pg8::Gemm g{(const bf16_t*)(ws + WS_HA), (const bf16_t*)WT_L, DM}; pg8::SegOrder S; S.init(64, 28, 4, lastl ? 14 : 28, G, bid, 32); pg8::EpiU E{(bf16_t*)(ws + WS_U), INW}; pg8::gemm_phase(ldsl, g, S, E, tid); }
        GSYNC; }
        REP(3) { { PHASE_BEGIN
          const int tid_ = tid;
          const bf16_t* U = (const bf16_t*)(ws + WS_U); bf16_t* MIX = (bf16_t*)(ws + WS_MIX);
          const int nNAc = lastl ? 0 : 32, nNA = 512 + nNAc, nHG = 0, nCV = lastl ? 256 : 272;
          hg_local_static(P, l, U, 32 * NCHUNK, bid, G, lds, opaque_v(tid_));
          DYN_LOOP_BEGIN(l * 2 + 0, nNA + nHG + nCV)
              const int tid = opaque_v(tid_), lane = tid & 63;
              if (it < 512) { const int hp = it & 3, rp = (it >> 2) & 31, b = it >> 7; REP(9) na_item(P, l, U, MIX, b * SEQ + rp * 128, b, 2 * rp, hp, true, lds, tid); }
              else if (it < nNA) { const int i2 = it - 512, hp = i2 & 3, qk = (i2 >> 2) & 1, b = i2 >> 3; na_item(P, l, U, MIX, ML + b * CTXL + qk * 128, b, 0, hp, false, lds, tid); }
              else if (it < nNA + nHG) { REP(10) hg_local_item(P, l, U, it - nNA, lds, tid); }
              else { const int t0 = (it - nNA - nHG) * 64;
                  cv_rows8(P, l, U, MIX, t0 + wave * 8, lane); }
          DYN_LOOP_END }
        GSYNC; }
        REP(4) { { PHASE_BEGIN hg_scan(P, tid, bid, G); }
        GSYNC; }
        REP(5) { { PHASE_BEGIN
          const int tid_ = tid;
          const bf16_t* U = (const bf16_t*)(ws + WS_U); bf16_t* MIX = (bf16_t*)(ws + WS_MIX);
          const int nit = lastl ? 1024 : 1088;
          DYN_LOOP_BEGIN(l * 2 + 1, nit)
              const int tid = opaque_v(tid_);
              int b, h, pc; if (lastl) { pc = 4 + (it & 63); h = (it >> 6) & 3; b = it >> 8; } else { pc = it % NCHUNK; h = (it / NCHUNK) & 3; b = it / (NCHUNK * 4); }
              hg_out_item(P, l, U, MIX, b, h, pc, lds, tid);
          DYN_LOOP_END
          }
        GSYNC; }
        REP(6) { { PHASE_BEGIN
          const float* xin_l = lastl ? (const float*)(ws + WS_X2B) : P.x; const float* xin_c = P.ctx; float* X1 = (float*)(ws + WS_X1);
          pg8::Gemm g{(const bf16_t*)(ws + WS_MIX), (const bf16_t*)(WT_L + WT_OUT_OFF), DM}; pg8::SegOrder S; S.init(64, 8, 4, lastl ? 0 : 8, G, bid, 32, 4);
          pg8::EpiRes E{xin_l, xin_c, X1, (float*)(ws + WS_PART), ADA_L, 2, 32, true, lastl}; pg8::gemm_phase(ldsl, g, S, E, tid); }
        GSYNC; }
        REP(1) { { PHASE_BEGIN
          float* X1 = (float*)(ws + WS_X1);
          phase_norm(true, X1, P.ctx, lastl ? nullptr : (const float*)(ws + WS_PART), P.ln2_w + l * DM, ADA_L, 3, lastl ? ML : MA, (bf16_t*)(ws + WS_HA), lastl ? nullptr : X1 + (size_t)ML * DM, gw, NGW, lane); }
        GSYNC; }
        REP(7) { { PHASE_BEGIN
          pg8::Gemm g{(const bf16_t*)(ws + WS_HA), (const bf16_t*)(WT_L + WT_UP_OFF), DM}; pg8::SegOrder S; S.init(64, 44, 4, lastl ? 0 : 44, G, bid, 32);
          pg8::EpiUp E{(bf16_t*)(ws + WS_U), (float*)(ws + WS_EDGE), P.f_cw + (size_t)l * 3 * FF2, P.f_cb + (size_t)l * FF2}; pg8::gemm_phase(ldsl, g, S, E, tid); }
        GSYNC; }
        REP(1) { { PHASE_BEGIN
          phase_fix((const float*)(ws + WS_EDGE), (bf16_t*)(ws + WS_U), P.f_cw + (size_t)l * 3 * FF2, P.f_cb + (size_t)l * FF2, lastl ? 256 : 272, gw, NGW, lane); }
        GSYNC; }
        REP(8) { { PHASE_BEGIN
          float* X1 = (float*)(ws + WS_X1);
          pg8::Gemm g{(const bf16_t*)(ws + WS_U), (const bf16_t*)(WT_L + WT_DN_OFF), FF}; pg8::SegOrder S; S.init(64, 8, 4, lastl ? 0 : 8, G, bid, 88, 4);
          pg8::EpiRes E{X1, X1 + (size_t)ML * DM, lastl ? P.out : (float*)(ws + WS_X2B), (float*)(ws + WS_PART), ADA_L, 5, 88, !lastl, true}; pg8::gemm_phase(ldsl, g, S, E, tid); }
        if (!lastl) GSYNC; }
    }
}

extern "C" void kernel_launch(void* const* d_in, const int* in_sizes, int n_in, void* d_out, int out_size, void* d_ws, size_t ws_size, hipStream_t stream) {
    static int grid = 0;
    if (grid == 0) {
        if (n_in != 22 || out_size != ML * DM || ws_size < WS_END) { fprintf(stderr, "kernel_launch: unexpected shapes (n_in %d, out %d, ws %zu); nothing launched\n", n_in, out_size, ws_size); grid = -1; return; }
        int dev = 0, cus = 0, per_cu = 0;
        if (hipGetDevice(&dev) != hipSuccess || hipDeviceGetAttribute(&cus, hipDeviceAttributeMultiprocessorCount, dev) != hipSuccess) { grid = -1; return; }
        if (hipFuncSetAttribute((const void*)mega, hipFuncAttributeMaxDynamicSharedMemorySize, LDS_BYTES) != hipSuccess) { fprintf(stderr, "kernel_launch: hipFuncSetAttribute failed\n"); grid = -1; return; }
        if (hipOccupancyMaxActiveBlocksPerMultiprocessor(&per_cu, (const void*)mega, 512, LDS_BYTES) != hipSuccess || per_cu < 1) per_cu = 1;
        (void)hipGetLastError();
        grid = cus;
    }
    if (grid < 0) return;
    Params p{};
    const float** pp = (const float**)&p;
    for (int i = 0; i < 22; ++i) pp[i] = (const float*)d_in[i];
    p.out = (float*)d_out; p.ws = (unsigned char*)d_ws;
    void* args[] = {&p};
    hipError_t e = hipLaunchCooperativeKernel((const void*)mega, dim3(grid), dim3(512), args, LDS_BYTES, stream);
    if (e != hipSuccess) fprintf(stderr, "cooperative launch failed: %s (grid %d)\n", hipGetErrorString(e), grid);
}
```
